# Optimizing an MI355X kernel written in HIP

```python
import jax, jax.numpy as jnp
from jax import lax
import numpy as np

D_MODEL = 2048
BATCH = 2
SEQ = 4096
DEPTH = 4
DEC_BATCH = 16
DEC_SEQ = 32
PAST_LEN = 4096

CHUNK = 64
CONV_DIM = 1024
CONV_WIDTH = 31
GMLP_DIM = 1024
GMLP_GROUPS = 8
GMLP_GC = GMLP_DIM // GMLP_GROUPS
GMLP_CHUNK = 128
N_HEADS = 8
HEAD_DIM = 128
ATTN_DIM = N_HEADS * HEAD_DIM
LEFT_CHUNKS = 8
ATTN_REACH = LEFT_CHUNKS * CHUNK
REL_CLIP = 128
D_FF = 4 * D_MODEL
PLE_DIM = 256
N_BRANCH = 3
EPS = 1e-6
IN_SPLITS = (2 * CONV_DIM,
             2 * CONV_DIM + 2 * GMLP_DIM,
             2 * CONV_DIM + 2 * GMLP_DIM + ATTN_DIM,
             2 * CONV_DIM + 2 * GMLP_DIM + 2 * ATTN_DIM,
             2 * CONV_DIM + 2 * GMLP_DIM + 3 * ATTN_DIM)
IN_COLS = 2 * CONV_DIM + 2 * GMLP_DIM + 3 * ATTN_DIM + N_BRANCH * D_MODEL

kernel_name = 'hybrid_streaming_encoder_step'


def rmsnorm(x, g):
    xf = x.astype(jnp.float32)
    y = xf * lax.rsqrt(jnp.mean(xf * xf, axis=-1, keepdims=True) + EPS)
    return (y * g.astype(jnp.float32)).astype(x.dtype)


def layernorm(x, g, b):
    xf = x.astype(jnp.float32)
    mu = jnp.mean(xf, axis=-1, keepdims=True)
    xc = xf - mu
    var = jnp.mean(xc * xc, axis=-1, keepdims=True)
    y = xc * lax.rsqrt(var + EPS) * g.astype(jnp.float32) + b.astype(jnp.float32)
    return y.astype(x.dtype)


def conv_module(za, conv_cache, conv_w, conv_b, ln_g, ln_b, w_a):
    a = za[..., :CONV_DIM] * jax.nn.sigmoid(za[..., CONV_DIM:])
    if conv_cache is None:
        left = jnp.zeros((a.shape[0], CONV_WIDTH - 1, CONV_DIM), a.dtype)
    else:
        left = conv_cache.astype(a.dtype)
    a_ext = jnp.concatenate([left, a], axis=1)
    y = lax.conv_general_dilated(a_ext, conv_w[:, None, :].astype(a.dtype), (1,), 'VALID',
                                 dimension_numbers=('NWC', 'WIO', 'NWC'),
                                 feature_group_count=CONV_DIM) + conv_b
    y = jax.nn.silu(layernorm(y, ln_g, ln_b))
    return y @ w_a, a_ext[:, -(CONV_WIDTH - 1):]


def gmlp_spatial(v, w_s, b_s):
    bsz, t = v.shape[0], v.shape[1]
    nb = -(-t // GMLP_CHUNK)
    tp = nb * GMLP_CHUNK
    vp = jnp.pad(v, ((0, 0), (0, tp - t), (0, 0), (0, 0)))
    vp = vp.reshape(bsz, nb, GMLP_CHUNK, GMLP_GROUPS, GMLP_GC)
    mask = jnp.tril(jnp.ones((GMLP_CHUNK, GMLP_CHUNK), dtype=bool))
    ws = jnp.where(mask[None], w_s, 0)
    out = jnp.einsum('gts,bnsgc->bntgc', ws, vp) + jnp.transpose(b_s)[None, None, :, :, None]
    return out.reshape(bsz, tp, GMLP_DIM)[:, :t]


def rel_bias(rel_tab, rel):
    idx = jnp.clip(rel, -REL_CLIP, REL_CLIP) + REL_CLIP
    return rel_tab[:, idx].astype(jnp.float32)


def band_attention_prompt(q, k, v, rel_tab):
    bsz, t = q.shape[0], q.shape[1]
    nc = t // CHUNK
    nband = (LEFT_CHUNKS + 1) * CHUNK
    pad = ((0, 0), (ATTN_REACH, 0), (0, 0), (0, 0))
    kp = jnp.pad(k, pad).reshape(bsz, nc + LEFT_CHUNKS, CHUNK, N_HEADS, HEAD_DIM)
    vp = jnp.pad(v, pad).reshape(bsz, nc + LEFT_CHUNKS, CHUNK, N_HEADS, HEAD_DIM)
    kb = jnp.concatenate([kp[:, j:j + nc] for j in range(LEFT_CHUNKS + 1)], axis=2)
    vb = jnp.concatenate([vp[:, j:j + nc] for j in range(LEFT_CHUNKS + 1)], axis=2)
    qc = q.reshape(bsz, nc, CHUNK, N_HEADS, HEAD_DIM)
    s = jnp.einsum('bnqhd,bnkhd->bnhqk', qc, kb).astype(jnp.float32) * (HEAD_DIM ** -0.5)
    k_off = jnp.arange(nband) - ATTN_REACH
    rel = jnp.arange(CHUNK)[:, None] - k_off[None, :]
    s = s + rel_bias(rel_tab, rel)[None, None]
    valid = (jnp.arange(nc)[:, None] * CHUNK + k_off[None, :]) >= 0
    s = jnp.where(valid[None, :, None, None, :], s, -1e30)
    p = jax.nn.softmax(s, axis=-1).astype(v.dtype)
    o = jnp.einsum('bnhqk,bnkhd->bnqhd', p, vb)
    return o.reshape(bsz, t, N_HEADS, HEAD_DIM)


def band_attention_sample(q, k, v, k_cache, v_cache, rel_tab):
    s_len = q.shape[1]
    w = k_cache.shape[1]
    kk = jnp.concatenate([k_cache.astype(k.dtype), k], axis=1)
    vv = jnp.concatenate([v_cache.astype(v.dtype), v], axis=1)
    s = jnp.einsum('bqhd,bkhd->bhqk', q, kk).astype(jnp.float32) * (HEAD_DIM ** -0.5)
    rel = jnp.arange(s_len)[:, None] + w - jnp.arange(w + s_len)[None, :]
    s = s + rel_bias(rel_tab, rel)[None]
    p = jax.nn.softmax(s, axis=-1).astype(v.dtype)
    return jnp.einsum('bhqk,bkhd->bqhd', p, vv)


def layer(h, ple, conv_cache, k_cache, v_cache, w):
    (g_mix, w_in, conv_w, conv_b, conv_ln_g, conv_ln_b, w_a,
     gm_ln_g, gm_ln_b, gm_ws, gm_bs, w_b, rel_tab, w_c, w_o,
     g_ffn, w_ff1, w_ff2, g_ple, w_ple_gate, w_ple_proj) = w
    bsz, t = h.shape[0], h.shape[1]
    xn = rmsnorm(h, g_mix)
    z = jnp.einsum('btd,dc->btc', xn, w_in)
    za, zb, zq, zk, zv, zg = jnp.split(z, IN_SPLITS, axis=-1)
    ya, conv_state = conv_module(za, conv_cache, conv_w, conv_b, conv_ln_g, conv_ln_b, w_a)
    u, v = jnp.split(jax.nn.gelu(zb), 2, axis=-1)
    v = layernorm(v, gm_ln_g, gm_ln_b)
    yb = (u * gmlp_spatial(v.reshape(bsz, t, GMLP_GROUPS, GMLP_GC), gm_ws, gm_bs)) @ w_b
    q = zq.reshape(bsz, t, N_HEADS, HEAD_DIM)
    k = zk.reshape(bsz, t, N_HEADS, HEAD_DIM)
    vv = zv.reshape(bsz, t, N_HEADS, HEAD_DIM)
    if k_cache is None:
        o = band_attention_prompt(q, k, vv, rel_tab)
        reach = min(ATTN_REACH, t)
        k_rows, v_rows = k[:, t - reach:], vv[:, t - reach:]
    else:
        o = band_attention_sample(q, k, vv, k_cache, v_cache, rel_tab)
        k_rows, v_rows = k, vv
    yc = o.reshape(bsz, t, ATTN_DIM) @ w_c
    gates = jax.nn.sigmoid(zg.reshape(bsz, t, N_BRANCH, D_MODEL))
    merged = gates[:, :, 0] * ya + gates[:, :, 1] * yb + gates[:, :, 2] * yc
    h = h + merged @ w_o
    hn = rmsnorm(h, g_ffn)
    h = h + jnp.square(jax.nn.relu(hn @ w_ff1)) @ w_ff2
    gate = jax.nn.sigmoid(rmsnorm(h, g_ple) @ w_ple_gate)
    h = h + gate * (ple @ w_ple_proj)
    return h, conv_state, k_rows, v_rows, v


def setup_inputs(seed: int = 0) -> dict:
    key = jax.random.key(seed)
    ks = jax.random.split(key, 32)

    def nrm(k, shape, scale):
        return jax.random.normal(k, shape, jnp.float32) * scale

    w_cache = min(ATTN_REACH, PAST_LEN)
    return {
        'x_prompt': nrm(ks[0], (BATCH, SEQ, D_MODEL), 1.0),
        'x_sample': nrm(ks[1], (DEC_BATCH, DEC_SEQ, D_MODEL), 1.0),
        'p_prompt': nrm(ks[2], (DEPTH, BATCH, SEQ, PLE_DIM), 1.0),
        'p_sample': nrm(ks[3], (DEPTH, DEC_BATCH, DEC_SEQ, PLE_DIM), 1.0),
        'cache_conv': nrm(ks[4], (DEPTH, DEC_BATCH, CONV_WIDTH - 1, CONV_DIM), 0.5),
        'cache_k': nrm(ks[5], (DEPTH, DEC_BATCH, w_cache, N_HEADS, HEAD_DIM), 1.0),
        'cache_v': nrm(ks[6], (DEPTH, DEC_BATCH, w_cache, N_HEADS, HEAD_DIM), 1.0),
        'norm_mix': 1.0 + nrm(ks[7], (DEPTH, D_MODEL), 0.02),
        'w_in': nrm(ks[8], (DEPTH, D_MODEL, IN_COLS), D_MODEL ** -0.5),
        'conv_w': nrm(ks[9], (DEPTH, CONV_WIDTH, CONV_DIM), CONV_WIDTH ** -0.5),
        'conv_b': nrm(ks[10], (DEPTH, CONV_DIM), 0.02),
        'conv_ln_g': 1.0 + nrm(ks[11], (DEPTH, CONV_DIM), 0.02),
        'conv_ln_b': nrm(ks[12], (DEPTH, CONV_DIM), 0.02),
        'w_a_out': nrm(ks[13], (DEPTH, CONV_DIM, D_MODEL), CONV_DIM ** -0.5),
        'gmlp_ln_g': 1.0 + nrm(ks[14], (DEPTH, GMLP_DIM), 0.02),
        'gmlp_ln_b': nrm(ks[15], (DEPTH, GMLP_DIM), 0.02),
        'gmlp_ws': nrm(ks[16], (DEPTH, GMLP_GROUPS, GMLP_CHUNK, GMLP_CHUNK), 0.5 * GMLP_CHUNK ** -0.5),
        'gmlp_bs': 1.0 + nrm(ks[17], (DEPTH, GMLP_GROUPS, GMLP_CHUNK), 0.02),
        'w_b_out': nrm(ks[18], (DEPTH, GMLP_DIM, D_MODEL), GMLP_DIM ** -0.5),
        'attn_rel_bias': nrm(ks[19], (DEPTH, N_HEADS, 2 * REL_CLIP + 1), 0.5),
        'w_c_out': nrm(ks[20], (DEPTH, ATTN_DIM, D_MODEL), ATTN_DIM ** -0.5),
        'w_o': nrm(ks[21], (DEPTH, D_MODEL, D_MODEL), D_MODEL ** -0.5),
        'norm_ffn': 1.0 + nrm(ks[22], (DEPTH, D_MODEL), 0.02),
        'w_ff1': nrm(ks[23], (DEPTH, D_MODEL, D_FF), D_MODEL ** -0.5),
        'w_ff2': nrm(ks[24], (DEPTH, D_FF, D_MODEL), D_FF ** -0.5),
        'norm_ple': 1.0 + nrm(ks[25], (DEPTH, D_MODEL), 0.02),
        'w_ple_gate': nrm(ks[26], (DEPTH, D_MODEL, D_MODEL), D_MODEL ** -0.5),
        'w_ple_proj': nrm(ks[27], (DEPTH, PLE_DIM, D_MODEL), PLE_DIM ** -0.5),
        'norm_final': 1.0 + nrm(ks[28], (D_MODEL,), 0.02),
    }


def reference(x_prompt, x_sample, p_prompt, p_sample, cache_conv, cache_k, cache_v,
              norm_mix, w_in, conv_w, conv_b, conv_ln_g, conv_ln_b, w_a_out,
              gmlp_ln_g, gmlp_ln_b, gmlp_ws, gmlp_bs, w_b_out, attn_rel_bias, w_c_out, w_o,
              norm_ffn, w_ff1, w_ff2, norm_ple, w_ple_gate, w_ple_proj, norm_final):
    h_p, h_s = x_prompt, x_sample
    conv_p, conv_s, kp_rows, vp_rows, ks_rows, vs_rows, gv_s = [], [], [], [], [], [], []
    for i in range(DEPTH):
        w = (norm_mix[i], w_in[i], conv_w[i], conv_b[i], conv_ln_g[i], conv_ln_b[i], w_a_out[i],
             gmlp_ln_g[i], gmlp_ln_b[i], gmlp_ws[i], gmlp_bs[i], w_b_out[i], attn_rel_bias[i],
             w_c_out[i], w_o[i], norm_ffn[i], w_ff1[i], w_ff2[i], norm_ple[i], w_ple_gate[i],
             w_ple_proj[i])
        h_p, c_p, k_p, v_p, _ = layer(h_p, p_prompt[i], None, None, None, w)
        h_s, c_s, k_s, v_s, g_s = layer(h_s, p_sample[i], cache_conv[i], cache_k[i], cache_v[i], w)
        conv_p.append(c_p)
        conv_s.append(c_s)
        kp_rows.append(k_p)
        vp_rows.append(v_p)
        ks_rows.append(k_s)
        vs_rows.append(v_s)
        gv_s.append(g_s)
    y_prompt = rmsnorm(h_p, norm_final)
    y_sample = rmsnorm(h_s, norm_final)
    conv_state_prompt = jnp.stack(conv_p)
    conv_state_sample = jnp.stack(conv_s)
    k_rows_prompt = jnp.stack(kp_rows)
    v_rows_prompt = jnp.stack(vp_rows)
    k_rows_sample = jnp.stack(ks_rows)
    v_rows_sample = jnp.stack(vs_rows)
    gmlp_v_sample = jnp.stack(gv_s)
    return (y_prompt, y_sample, conv_state_prompt, conv_state_sample, k_rows_prompt, v_rows_prompt,
            k_rows_sample, v_rows_sample, gmlp_v_sample)
```

```cpp
#include <hip/hip_runtime.h>
#include <cstdio>
#include <cstdint>
namespace pg8 {
#define PG8_LAS __attribute__((address_space(3)))
typedef unsigned short bf16_t;
typedef short bf16x8 __attribute__((ext_vector_type(8)));
typedef float f32x4 __attribute__((ext_vector_type(4)));
typedef unsigned u32x4 __attribute__((ext_vector_type(4)));
constexpr int BM = 256, BK = 64, HALF = 128, HTB = HALF * BK * 2  , STAGE_BYTES = 8 * HTB, NXCD = 8, WGM = 8;

__host__ __device__ __forceinline__ int lds_byte(int r, int c) { const int st = (r >> 4) * 2 + (c >> 5), rr = r & 15, cc = c & 31, ob = rr * 64 + cc * 2; return st * 1024 + (ob ^ (((ob >> 9) & 1) << 5)); }
__host__ __device__ __forceinline__ void stage_rc(int b, int& R, int& C) { const int st = b / 1024, sb = b % 1024, swz = sb ^ (((sb >> 9) & 1) << 5); R = (st >> 1) * 16 + swz / 64; C = (st & 1) * 32 + (swz % 64) / 2; }
__host__ __device__ __forceinline__ int perm32(int rho) { const int n = rho >> 4, i = rho & 15; return 8 * (i >> 2) + 4 * n + (i & 3); }

struct Unit { int pm, pn; };
struct Gemm { const bf16_t* A; const bf16_t* Bt; int M, N, K; };

struct StaticOrder {
    int nM, nN, nwg, G, c;
    __host__ __device__ void init(int M, int N, int G_, int c_) { nM = M / BM; nN = N / BM; nwg = nM * nN; G = G_; c = c_; }
    __host__ __device__ bool next(int i, Unit& u) const {
        const long L = (long)i * G + c; if (L >= nwg) return false;
        int wgid = (int)L; { const int q = nwg / NXCD, r = nwg % NXCD, xcd = wgid % NXCD, off = wgid / NXCD; wgid = (xcd < r ? xcd * (q + 1) : r * (q + 1) + (xcd - r) * q) + off; }
        const int nig = WGM * nN, gid = wgid / nig, fm = gid * WGM, gsz = (nM - fm) < WGM ? (nM - fm) : WGM;
        u.pm = fm + ((wgid % nig) % gsz); u.pn = (wgid % nig) / gsz; return true;
    }
    __device__ __forceinline__ void a_ready(const Unit&) const {}
    __device__ __forceinline__ void done(const Unit&) const {}
};
__device__ __forceinline__ unsigned cvt_pk_bf16(float lo, float hi) { unsigned r; asm volatile("v_cvt_pk_bf16_f32 %0, %1, %2" : "=v"(r) : "v"(lo), "v"(hi)); return r; }
typedef unsigned u32x2 __attribute__((ext_vector_type(2)));
__device__ __forceinline__ float bf_lo(unsigned w) { return __uint_as_float(w << 16); }
__device__ __forceinline__ float bf_hi(unsigned w) { return __uint_as_float(w & 0xffff0000u); }
__device__ __forceinline__ float sigm(float x) { return 1.0f / (1.0f + __expf(-x)); }

template <int ACT> struct EpiBf16 {
    static constexpr bool PERM = true, AFTER_DRAIN = false;
    bf16_t* O; int ldc;
    __device__ __forceinline__ void operator()(const f32x4 (&acc)[2][2][4][2], const Unit& u, int wr, int wc, int fr, int fq) const {
        const int row0 = u.pm * BM + wr * 64 + fr, col0 = u.pn * BM + wc * 32 + 8 * fq;
#pragma unroll
        for (int ai = 0; ai < 2; ++ai)
#pragma unroll
            for (int m = 0; m < 4; ++m) { bf16_t* rowp = O + (size_t)(row0 + ai * HALF + m * 16) * ldc + col0;
#pragma unroll
                for (int bj = 0; bj < 2; ++bj) { f32x4 v0 = acc[ai][bj][m][0], v1 = acc[ai][bj][m][1];
                    if (ACT == 1) {
#pragma unroll
                        for (int j = 0; j < 4; ++j) { const float a = fmaxf(v0[j], 0.f), b = fmaxf(v1[j], 0.f); v0[j] = a * a; v1[j] = b * b; } }
                    u32x4 w; w.x = cvt_pk_bf16(v0[0], v0[1]); w.y = cvt_pk_bf16(v0[2], v0[3]); w.z = cvt_pk_bf16(v1[0], v1[1]); w.w = cvt_pk_bf16(v1[2], v1[3]);
                    *(u32x4*)(rowp + bj * HALF) = w; } }
    }
};
struct EpiResAdd {
    static constexpr bool PERM = false, AFTER_DRAIN = false;
    float* H; int ldc;
    __device__ __forceinline__ void operator()(const f32x4 (&acc)[2][2][4][2], const Unit& u, int wr, int wc, int fr, int fq) const {
        const int row0 = u.pm * BM + wr * 64 + fr, col0 = u.pn * BM + wc * 32 + 4 * fq;
#pragma unroll
        for (int ai = 0; ai < 2; ++ai)
#pragma unroll
            for (int m = 0; m < 4; ++m) { float* rowp = H + (size_t)(row0 + ai * HALF + m * 16) * ldc + col0;
#pragma unroll
                for (int bj = 0; bj < 2; ++bj)
#pragma unroll
                    for (int n = 0; n < 2; ++n) { float* p = rowp + bj * HALF + n * 16; const f32x4 b = *(const f32x4*)p; *(f32x4*)p = b + acc[ai][bj][m][n]; }
                if (m & 1) asm volatile("" ::: "memory"); }
    }
};
template <int MODE> struct EpiBranch {
    static constexpr bool PERM = false, AFTER_DRAIN = false;
    const bf16_t* Zg; int ldz; float* MG; bf16_t* OUT; int ldc;
    __device__ __forceinline__ void operator()(const f32x4 (&acc)[2][2][4][2], const Unit& u, int wr, int wc, int fr, int fq) const {
        const int row0 = u.pm * BM + wr * 64 + fr, col0 = u.pn * BM + wc * 32 + 4 * fq;
#pragma unroll
        for (int ai = 0; ai < 2; ++ai)
#pragma unroll
            for (int m = 0; m < 4; ++m) { const size_t r = (size_t)(row0 + ai * HALF + m * 16);
#pragma unroll
                for (int bj = 0; bj < 2; ++bj)
#pragma unroll
                    for (int n = 0; n < 2; ++n) { const int c = col0 + bj * HALF + n * 16;
                        const u32x2 gw = *(const u32x2*)(Zg + r * ldz + c);
                        f32x4 g; g[0] = sigm(bf_lo(gw.x)); g[1] = sigm(bf_hi(gw.x)); g[2] = sigm(bf_lo(gw.y)); g[3] = sigm(bf_hi(gw.y));
                        f32x4 v = g * acc[ai][bj][m][n];
                        float* mp = MG + r * ldc + c;
                        if (MODE == 0) { *(f32x4*)mp = v; }
                        else if (MODE == 1) { const f32x4 b = *(const f32x4*)mp; *(f32x4*)mp = b + v; }
                        else { const f32x4 b = *(const f32x4*)mp; v = b + v; u32x2 w; w.x = cvt_pk_bf16(v[0], v[1]); w.y = cvt_pk_bf16(v[2], v[3]); *(u32x2*)(OUT + r * ldc + c) = w; } }
                if (m & 1) asm volatile("" ::: "memory"); }
    }
};
struct EpiPle {
    static constexpr bool PERM = false, AFTER_DRAIN = false;
    float* H; const bf16_t* PP; int ldc;
    __device__ __forceinline__ void operator()(const f32x4 (&acc)[2][2][4][2], const Unit& u, int wr, int wc, int fr, int fq) const {
        const int row0 = u.pm * BM + wr * 64 + fr, col0 = u.pn * BM + wc * 32 + 4 * fq;
#pragma unroll
        for (int ai = 0; ai < 2; ++ai)
#pragma unroll
            for (int m = 0; m < 4; ++m) { const size_t r = (size_t)(row0 + ai * HALF + m * 16);
#pragma unroll
                for (int bj = 0; bj < 2; ++bj)
#pragma unroll
                    for (int n = 0; n < 2; ++n) { const int c = col0 + bj * HALF + n * 16;
                        const u32x2 pw = *(const u32x2*)(PP + r * ldc + c);
                        f32x4 pv; pv[0] = bf_lo(pw.x); pv[1] = bf_hi(pw.x); pv[2] = bf_lo(pw.y); pv[3] = bf_hi(pw.y);
                        const f32x4 a = acc[ai][bj][m][n]; f32x4 g; g[0] = sigm(a[0]); g[1] = sigm(a[1]); g[2] = sigm(a[2]); g[3] = sigm(a[3]);
                        float* p = H + r * ldc + c; const f32x4 b = *(const f32x4*)p; *(f32x4*)p = b + g * pv; }
                if (m & 1) asm volatile("" ::: "memory"); }
    }
};

template <class Epi, class Sched, bool ALIGN_EPI = false, bool SP2 = false>
__device__ __forceinline__ void gemm_phase(PG8_LAS unsigned char* lds, const Gemm g, const Sched& S, const Epi& E) {
    int tid_ = threadIdx.x; asm volatile("" : "+v"(tid_));
    const int tid = tid_, wid = __builtin_amdgcn_readfirstlane(tid >> 6), lane = tid & 63, wr = wid >> 2, wc = wid & 3, fr = lane & 15, fq = lane >> 4;
    const int K = g.K, nt = K / BK;
    unsigned voffA[2], voffB[2];
#pragma unroll
    for (int i = 0; i < 2; ++i) { int R, C; stage_rc(tid * 16 + i * 8192, R, C); const int Rb = Epi::PERM ? ((R & ~31) + perm32(R & 31)) : R;
        voffA[i] = (unsigned)(R * K + C) * 2u; voffB[i] = (unsigned)(Rb * K + C) * 2u; }
    const size_t kstep = (size_t)(BK * 2);
    const size_t hstep = (size_t)HALF * K * 2;
    const size_t tstep = 2 * hstep;
    const unsigned ldsw = (unsigned)wid * 1024u;
    const int aoff = lds_byte(wr * 64 + fr, fq * 8), boff = lds_byte(wc * 32 + fr, fq * 8);
#define PG8_SA(b, h) (((b) * 2 + (h)) * HTB)
#define PG8_SB(b, h) ((4 + (b) * 2 + (h)) * HTB)
#define PG8_STAGE(bufoff, gbase, voff) do { _Pragma("unroll") for (int _i = 0; _i < 2; ++_i) \
        __builtin_amdgcn_global_load_lds((const unsigned*)((const char*)(gbase) + (voff)[_i]), (PG8_LAS unsigned*)(lds + (bufoff) + ldsw + _i * 8192), 16, 0, 0); } while (0)
#define PG8_LDA(dst, b, h) do { _Pragma("unroll") for (int m = 0; m < 4; ++m) _Pragma("unroll") for (int k = 0; k < 2; ++k) dst[m][k] = *(const PG8_LAS bf16x8*)(lds + PG8_SA(b, h) + aoff + m * 2048 + k * 1024); } while (0)
#define PG8_LDB(dst, b, h) do { _Pragma("unroll") for (int n = 0; n < 2; ++n) _Pragma("unroll") for (int k = 0; k < 2; ++k) dst[n][k] = *(const PG8_LAS bf16x8*)(lds + PG8_SB(b, h) + boff + n * 2048 + k * 1024); } while (0)
#define PG8_MMA(ai, bj, At, Bt) do { __builtin_amdgcn_s_setprio(1); _Pragma("unroll") for (int m = 0; m < 4; ++m) _Pragma("unroll") for (int n = 0; n < 2; ++n) _Pragma("unroll") for (int k = 0; k < 2; ++k) \
        acc[ai][bj][m][n] = __builtin_amdgcn_mfma_f32_16x16x32_bf16(Bt[n][k], At[m][k], acc[ai][bj][m][n], 0, 0, 0); __builtin_amdgcn_s_setprio(0); } while (0)
#define PG8_WAIT_V(n) asm volatile("s_waitcnt vmcnt(" #n ")" ::: "memory")
#define PG8_WAIT_L(n) asm volatile("s_waitcnt lgkmcnt(" #n ")" ::: "memory")
#define PG8_BAR __builtin_amdgcn_s_barrier()
#define PG8_SCHED __builtin_amdgcn_sched_barrier(0)
    Unit cur, nxt; int ui = 0;
    if (!S.next(0, cur)) return;
    f32x4 acc[2][2][4][2];
#pragma unroll
    for (int a = 0; a < 2; ++a)
#pragma unroll
        for (int b = 0; b < 2; ++b)
#pragma unroll
            for (int m = 0; m < 4; ++m)
#pragma unroll
                for (int n = 0; n < 2; ++n) acc[a][b][m][n] = (f32x4){0.f, 0.f, 0.f, 0.f};
    bf16x8 At[4][2], B0[2][2], B1[2][2];
    const char* cA = (const char*)g.A + (size_t)cur.pm * tstep; const char* cB = (const char*)g.Bt + (size_t)cur.pn * tstep;
    S.a_ready(cur);
    if constexpr (SP2) {
        PG8_STAGE(PG8_SB(0, 0), cB, voffB); PG8_STAGE(PG8_SB(0, 1), cB + hstep, voffB); PG8_STAGE(PG8_SA(0, 0), cA, voffA); PG8_STAGE(PG8_SA(0, 1), cA + hstep, voffA);
        if (wr == 1) PG8_BAR;
        PG8_WAIT_V(2); PG8_BAR;
        PG8_STAGE(PG8_SB(1, 0), cB + kstep, voffB); PG8_STAGE(PG8_SA(1, 0), cA + kstep, voffA); PG8_STAGE(PG8_SB(1, 1), cB + hstep + kstep, voffB);
        PG8_WAIT_V(6); PG8_BAR;
    } else {
        PG8_STAGE(PG8_SB(0, 0), cB, voffB); PG8_STAGE(PG8_SA(0, 0), cA, voffA); PG8_STAGE(PG8_SB(0, 1), cB + hstep, voffB); PG8_STAGE(PG8_SA(0, 1), cA + hstep, voffA);
        if (wr == 1) PG8_BAR;
        PG8_WAIT_V(4); PG8_BAR;
        PG8_STAGE(PG8_SB(1, 0), cB + kstep, voffB); PG8_STAGE(PG8_SA(1, 0), cA + kstep, voffA); PG8_STAGE(PG8_SB(1, 1), cB + hstep + kstep, voffB);
        PG8_WAIT_V(6); PG8_BAR;
    }
    for (;;) {
        const bool has_next = S.next(ui + 1, nxt);
        const char* nA = has_next ? (const char*)g.A + (size_t)nxt.pm * tstep : cA; const char* nB = has_next ? (const char*)g.Bt + (size_t)nxt.pn * tstep : cB;
        for (int t = 0; t < nt; t += 2) {
            const bool last = (t == nt - 2);
            const char* a1 = cA + (size_t)(t + 1) * kstep;
            const char* a2 = last ? nA : cA + (size_t)(t + 2) * kstep; const char* b2 = last ? nB : cB + (size_t)(t + 2) * kstep;
            const char* a3 = a2 + kstep; const char* b3 = b2 + kstep;
            if (last && has_next) S.a_ready(nxt);
            if constexpr (SP2) {
            PG8_LDB(B0, 0, 0); PG8_LDB(B1, 0, 1); PG8_SCHED; PG8_LDA(At, 0, 0); PG8_STAGE(PG8_SA(1, 1), a1 + hstep, voffA);
            PG8_WAIT_V(8); PG8_WAIT_L(0); PG8_BAR; PG8_MMA(0, 0, At, B0); PG8_MMA(0, 1, At, B1); PG8_BAR; PG8_SCHED;
            PG8_LDA(At, 0, 1); PG8_STAGE(PG8_SB(0, 0), b2, voffB); PG8_STAGE(PG8_SB(0, 1), b2 + hstep, voffB); PG8_STAGE(PG8_SA(0, 0), a2, voffA);
            PG8_WAIT_V(8); PG8_WAIT_L(0); PG8_BAR; PG8_MMA(1, 0, At, B0); PG8_MMA(1, 1, At, B1); PG8_BAR; PG8_SCHED;
            PG8_LDB(B0, 1, 0); PG8_LDB(B1, 1, 1); PG8_SCHED; PG8_LDA(At, 1, 0); PG8_STAGE(PG8_SA(0, 1), a2 + hstep, voffA);
            PG8_WAIT_V(8); PG8_WAIT_L(0); PG8_BAR; PG8_MMA(0, 0, At, B0); PG8_MMA(0, 1, At, B1); PG8_BAR; PG8_SCHED;
            PG8_LDA(At, 1, 1); PG8_STAGE(PG8_SB(1, 0), b3, voffB); PG8_STAGE(PG8_SB(1, 1), b3 + hstep, voffB); PG8_STAGE(PG8_SA(1, 0), a3, voffA);
            PG8_WAIT_V(8); PG8_WAIT_L(0); PG8_BAR; PG8_MMA(1, 0, At, B0); PG8_MMA(1, 1, At, B1); PG8_BAR; PG8_SCHED;
            } else {
            PG8_LDB(B0, 0, 0); PG8_SCHED; PG8_LDA(At, 0, 0); PG8_STAGE(PG8_SA(1, 1), a1 + hstep, voffA);
            PG8_WAIT_L(8); PG8_BAR; PG8_WAIT_L(0); PG8_MMA(0, 0, At, B0); PG8_BAR; PG8_SCHED;
            PG8_LDB(B1, 0, 1); PG8_STAGE(PG8_SB(0, 0), b2, voffB);
            PG8_BAR; PG8_WAIT_L(0); PG8_MMA(0, 1, At, B1); PG8_BAR;
            PG8_LDA(At, 0, 1); PG8_STAGE(PG8_SA(0, 0), a2, voffA);
            PG8_BAR; PG8_WAIT_L(0); PG8_MMA(1, 0, At, B0); PG8_BAR; PG8_SCHED;
            PG8_STAGE(PG8_SB(0, 1), b2 + hstep, voffB);
            PG8_WAIT_V(6); PG8_BAR; PG8_MMA(1, 1, At, B1); PG8_BAR;
            PG8_LDB(B0, 1, 0); PG8_SCHED; PG8_LDA(At, 1, 0); PG8_STAGE(PG8_SA(0, 1), a2 + hstep, voffA);
            PG8_WAIT_L(8); PG8_BAR; PG8_WAIT_L(0); PG8_MMA(0, 0, At, B0); PG8_BAR; PG8_SCHED;
            PG8_LDB(B1, 1, 1); PG8_STAGE(PG8_SB(1, 0), b3, voffB);
            PG8_BAR; PG8_WAIT_L(0); PG8_MMA(0, 1, At, B1); PG8_BAR;
            PG8_LDA(At, 1, 1); PG8_STAGE(PG8_SA(1, 0), a3, voffA);
            PG8_BAR; PG8_WAIT_L(0); PG8_MMA(1, 0, At, B0); PG8_BAR; PG8_SCHED;
            PG8_STAGE(PG8_SB(1, 1), b3 + hstep, voffB);
            PG8_WAIT_V(6); PG8_BAR; PG8_MMA(1, 1, At, B1); PG8_BAR;
            }
        }
        if constexpr (ALIGN_EPI) { if (wr == 0) PG8_BAR; }
        if constexpr (!Epi::AFTER_DRAIN) { E(acc, cur, wr, wc, fr, fq); S.done(cur); }
        if (!has_next) break;
#pragma unroll
        for (int a = 0; a < 2; ++a)
#pragma unroll
            for (int b = 0; b < 2; ++b)
#pragma unroll
                for (int m = 0; m < 4; ++m)
#pragma unroll
                    for (int n = 0; n < 2; ++n) acc[a][b][m][n] = (f32x4){0.f, 0.f, 0.f, 0.f};
        cur = nxt; cA = nA; cB = nB; ++ui;
        if constexpr (ALIGN_EPI) { if (wr == 1) PG8_BAR; }
    }
    PG8_WAIT_V(0);
    if constexpr (!ALIGN_EPI) { if (wr == 0) PG8_BAR; }
    PG8_BAR;
    if constexpr (Epi::AFTER_DRAIN) { E.fused(acc, cur, wr, wc, fr, fq, lds, wid, lane); S.done(cur); }
#undef PG8_SA
#undef PG8_SB
#undef PG8_STAGE
#undef PG8_LDA
#undef PG8_LDB
#undef PG8_MMA
#undef PG8_WAIT_V
#undef PG8_WAIT_L
#undef PG8_BAR
#undef PG8_SCHED
}
}
#ifndef PG8_SP2
#define PG8_SP2 true
#endif
#ifndef PG8_ALIGN
#define PG8_ALIGN true
#endif
#ifndef MK_PER_PHASE
#define MK_PER_PHASE 0
#endif

constexpr int NWAVES = 8;
constexpr int DM = 2048, DEPTH = 4, MP = 8192, MS = 512, MTOK = MP + MS;
constexpr int SEQ = 4096, DSEQ = 32, DBATCH = 16, PBATCH = 2;
constexpr int CONVD = 1024, CONVW = 31, GMD = 1024, NHEAD = 8, HDIM = 128, ATD = 1024, DFF = 8192, PLED = 256;
constexpr int INC = 13312, ZA = 0, ZB = 2048, ZQ = 4096, ZK = 5120, ZV = 6144, ZG = 7168;
constexpr int WCACHE = 512;
constexpr float EPS = 1e-6f;
constexpr size_t O_YP = 0, O_YS = 16777216, O_CSP = 17825792, O_CSS = 18071552, O_KP = 20037632, O_VP = 24231936, O_KS = 28426240, O_VS = 30523392, O_GV = 32620544, O_END = 34717696;
constexpr size_t MiB = 1u << 20;
constexpr size_t WS_CTL = 0, CTL_ZERO_BYTES = 1 * MiB;
constexpr size_t WS_WT = 1 * MiB, WT_LAYER = 145 * MiB;
constexpr size_t WT_IN = 0, WT_A = 52 * MiB, WT_B = 56 * MiB, WT_C = 60 * MiB, WT_O = 64 * MiB, WT_F1 = 72 * MiB, WT_F2 = 104 * MiB, WT_PG = 136 * MiB, WT_PP = 144 * MiB;
constexpr size_t WS_H = 581 * MiB, WS_XN = 649 * MiB, WS_Z = 683 * MiB, WS_YA = 904 * MiB, WS_YB = 921 * MiB, WS_O = 938 * MiB, WS_V = 955 * MiB, WS_MG = 972 * MiB, WS_MERGED = 1040 * MiB, WS_PP = 1074 * MiB, WS_PLE = 1108 * MiB, WS_END = 1125 * MiB;
constexpr size_t WS_T = WS_Z;
static_assert(WS_WT + 4 * WT_LAYER == WS_H && WS_Z + (size_t)MTOK * INC * 2 == WS_YA && WS_T + (size_t)MTOK * DFF * 2 <= WS_YA, "ws map");
constexpr int CW_BAR = 4096;

constexpr int RING_OFF = 0, RING_BYTES = 131072;
constexpr int LDSCTL_OFF = RING_BYTES, MISC_OFF = LDSCTL_OFF + 320;
constexpr int LDS_BYTES = 147456;

#define GAS __attribute__((address_space(1)))
#define LAS __attribute__((address_space(3)))
typedef unsigned short bf16;
typedef unsigned v4u __attribute__((ext_vector_type(4)));
typedef float f32x4 __attribute__((ext_vector_type(4)));
typedef short bf16x8 __attribute__((ext_vector_type(8)));
typedef GAS unsigned gu32;
typedef GAS unsigned long long gu64;
#define RLX_AGENT __ATOMIC_RELAXED, __HIP_MEMORY_SCOPE_AGENT
#define LDS_WAIT() asm volatile("s_waitcnt lgkmcnt(0)" ::: "memory")
#define VM_WAIT() asm volatile("s_waitcnt vmcnt(0)" ::: "memory")
__device__ __forceinline__ unsigned long long rt() { return __builtin_amdgcn_s_memrealtime(); }
__device__ __forceinline__ unsigned f2bf(float f) { unsigned u = __builtin_bit_cast(unsigned, f); return (u + 0x7fffu + ((u >> 16) & 1u)) >> 16; }
__device__ __forceinline__ unsigned pk2(float lo, float hi) { return f2bf(lo) | (f2bf(hi) << 16); }

#define XB_TMO      128
#define XB_XCNT(j)  (256  + 64 * (j))
#define XB_XSUB(j)  (1280 + 64 * (j))
#define XB_XGEN(j)  (2304 + 64 * (j))
#define XB_TOP      3328
#define XB_TOPGEN   3392
#define XCD_BAR_WORDS 3456
#define XB_SPIN_CAP (1u << 18)

__device__ __forceinline__ unsigned xb_ld(unsigned* p)              { return __hip_atomic_load(p, __ATOMIC_RELAXED, __HIP_MEMORY_SCOPE_AGENT); }
__device__ __forceinline__ unsigned xb_add(unsigned* p, unsigned v) { return __hip_atomic_fetch_add(p, v, __ATOMIC_RELAXED, __HIP_MEMORY_SCOPE_AGENT); }
__device__ __forceinline__ unsigned xb_xcc_id() { return (unsigned)__builtin_amdgcn_s_getreg((3 << 11) | 20) & 0xFu; }
#define XB_SPIN(cond, bar) do { unsigned _sp = 0; while (cond) { __builtin_amdgcn_s_sleep(1); \
    if ((++_sp & 255u) == 0u) { if (xb_ld(&(bar)[XB_TMO])) break; if (_sp > XB_SPIN_CAP) { atomicAdd(&(bar)[XB_TMO], 1u); break; } } } } while (0)

struct XcdBarrier {
    unsigned* bar; unsigned x;
    volatile LAS unsigned* st;
};

__device__ __forceinline__ XcdBarrier xcd_barrier_post(unsigned* bar, volatile LAS unsigned* st) {
    XcdBarrier b; b.bar = bar; b.x = xb_xcc_id(); b.st = st;
    if (threadIdx.x == 0) (void)xb_add(&bar[XB_XCNT(b.x)], 1u);
    return b;
}
__device__ __forceinline__ void xcd_barrier_complete(unsigned* bar, unsigned x, unsigned& nloc, unsigned& nx) {
    const unsigned G = gridDim.x * gridDim.y * gridDim.z;
    unsigned sum, cnt, mine, sp = 0u;
    for (;;) {
        sum = 0u; cnt = 0u; mine = 0u;
#pragma unroll
        for (unsigned j = 0; j < 16; ++j) { const unsigned c = xb_ld(&bar[XB_XCNT(j)]); sum += c; cnt += (c > 0u) ? 1u : 0u; mine = (j == x) ? c : mine; }
        if (sum == G) break;
        __builtin_amdgcn_s_sleep(1);
        if ((++sp & 255u) == 0u) { if (xb_ld(&bar[XB_TMO])) break; if (sp > XB_SPIN_CAP) { atomicAdd(&bar[XB_TMO], 1u); break; } }
    }
    nloc = mine > 0u ? mine : 1u; nx = cnt > 0u ? cnt : 1u;
}

__device__ __forceinline__ void xcd_barrier(const XcdBarrier& b) {
    asm volatile("s_waitcnt vmcnt(0)" ::: "memory");
    __syncthreads();
    if (threadIdx.x == 0) {
        unsigned* bar = b.bar;
        __builtin_amdgcn_s_waitcnt(0);
        unsigned nloc = b.st[0], nx = b.st[1];
        if (nloc == 0u) { xcd_barrier_complete(bar, b.x, nloc, nx); b.st[0] = nloc; b.st[1] = nx; }
        const unsigned old = xb_add(&bar[XB_XSUB(b.x)], 1u);
        const unsigned gen = old / nloc;
        if (old + 1u == (gen + 1u) * nloc) {
            __builtin_amdgcn_fence(__ATOMIC_RELEASE, "agent");
            asm volatile("s_waitcnt vmcnt(0)" ::: "memory");
            const unsigned og = xb_add(&bar[XB_TOP], 1u);
            const unsigned tg = og / nx;
            if (og + 1u == (tg + 1u) * nx) xb_add(&bar[XB_TOPGEN], 1u);
            else XB_SPIN(xb_ld(&bar[XB_TOPGEN]) == tg, bar);
            __builtin_amdgcn_fence(__ATOMIC_ACQUIRE, "agent");
            xb_add(&bar[XB_XGEN(b.x)], 1u);
            asm volatile("s_waitcnt vmcnt(0)" ::: "memory");
        } else {
            XB_SPIN(xb_ld(&bar[XB_XGEN(b.x)]) == gen, bar);
            __builtin_amdgcn_fence(__ATOMIC_ACQUIRE, "agent");
            asm volatile("s_waitcnt vmcnt(0)" ::: "memory");
        }
    }
    __syncthreads();
}
typedef unsigned u32x2g __attribute__((ext_vector_type(2)));
typedef float f32x2g __attribute__((ext_vector_type(2)));
__device__ __forceinline__ float wave_sum(float v) {
#pragma unroll
    for (int o = 1; o < 64; o <<= 1) v += __shfl_xor(v, o);
    return v;
}
__device__ __forceinline__ void unpack8(const v4u w, float (&f)[8]) { f[0] = pg8::bf_lo(w.x); f[1] = pg8::bf_hi(w.x); f[2] = pg8::bf_lo(w.y); f[3] = pg8::bf_hi(w.y); f[4] = pg8::bf_lo(w.z); f[5] = pg8::bf_hi(w.z); f[6] = pg8::bf_lo(w.w); f[7] = pg8::bf_hi(w.w); }
__device__ __forceinline__ v4u pack8(const float (&f)[8]) { v4u o; o.x = pk2(f[0], f[1]); o.y = pk2(f[2], f[3]); o.z = pk2(f[4], f[5]); o.w = pk2(f[6], f[7]); return o; }
__device__ __forceinline__ float gelu_tanh(float x) { return x * pg8::sigm(1.5957691216057308f * (x + 0.044715f * x * x * x)); }
__device__ __forceinline__ void load8f(const float* p, float (&f)[8]) { const f32x4 a = *(const f32x4*)p, b = *(const f32x4*)(p + 4); f[0] = a[0]; f[1] = a[1]; f[2] = a[2]; f[3] = a[3]; f[4] = b[0]; f[5] = b[1]; f[6] = b[2]; f[7] = b[3]; }
__device__ __forceinline__ void store8f(float* p, const float (&f)[8]) { *(f32x4*)p = (f32x4){f[0], f[1], f[2], f[3]}; *(f32x4*)(p + 4) = (f32x4){f[4], f[5], f[6], f[7]}; }

__device__ __forceinline__ void p0_transpose_item(const float* W, int K, int N, bf16* WT, LAS float* scr, int item, int lane) {
    const int nblk = N / 32, kb = item / nblk, nb = item % nblk, k0 = 64 * kb, n0 = 32 * nb;
#pragma unroll 8
    for (int i = 0; i < 32; ++i) { const int kk = 2 * i + (lane >> 5); scr[kk * 33 + (lane & 31)] = W[(size_t)(k0 + kk) * N + n0 + (lane & 31)]; }
    LDS_WAIT(); asm volatile("" ::: "memory");
    const int c = lane & 7;
#pragma unroll
    for (int j = 0; j < 4; ++j) { const int n = (lane >> 3) + 8 * j; const LAS float* s = scr + (8 * c) * 33 + n;
        v4u o; o.x = pk2(s[0 * 33], s[1 * 33]); o.y = pk2(s[2 * 33], s[3 * 33]); o.z = pk2(s[4 * 33], s[5 * 33]); o.w = pk2(s[6 * 33], s[7 * 33]);
        *(GAS v4u*)(WT + (size_t)(n0 + n) * K + k0 + 8 * c) = o; }
    LDS_WAIT(); asm volatile("" ::: "memory");
}

__device__ __forceinline__ void rms_row_bf16(const float* xrow, const float* gain, bf16* orow, int lane) {
    const f32x4* xr = (const f32x4*)xrow + lane; const f32x4* gr = (const f32x4*)gain + lane;
    f32x4 v[8]; float s = 0.f;
#pragma unroll
    for (int j = 0; j < 8; ++j) { v[j] = xr[64 * j]; s += (v[j][0] * v[j][0] + v[j][1] * v[j][1]) + (v[j][2] * v[j][2] + v[j][3] * v[j][3]); }
    const float rstd = 1.0f / sqrtf(wave_sum(s) * (1.f / DM) + EPS);
    u32x2g* o8 = (u32x2g*)orow + lane;
#pragma unroll
    for (int j = 0; j < 8; ++j) { const f32x4 g = gr[64 * j]; u32x2g w; w.x = pk2(v[j][0] * rstd * g[0], v[j][1] * rstd * g[1]); w.y = pk2(v[j][2] * rstd * g[2], v[j][3] * rstd * g[3]); o8[64 * j] = w; }
}
__device__ __forceinline__ void rms_row_f32(const float* xrow, const float* gain, float* orow, int lane) {
    const f32x4* xr = (const f32x4*)xrow + lane; const f32x4* gr = (const f32x4*)gain + lane;
    f32x4 v[8]; float s = 0.f;
#pragma unroll
    for (int j = 0; j < 8; ++j) { v[j] = xr[64 * j]; s += (v[j][0] * v[j][0] + v[j][1] * v[j][1]) + (v[j][2] * v[j][2] + v[j][3] * v[j][3]); }
    const float rstd = 1.0f / sqrtf(wave_sum(s) * (1.f / DM) + EPS);
    f32x4* o = (f32x4*)orow + lane;
#pragma unroll
    for (int j = 0; j < 8; ++j) { const f32x4 g = gr[64 * j]; o[64 * j] = v[j] * rstd * g; }
}

__device__ __forceinline__ void conv_row(int l, int row, const bf16* z, const float* cache_conv, const float* conv_w, const float* conv_b, const float* ln_g, const float* ln_b, bf16* ya, float* out, int lane) {
    const bool samp = row >= MP; const int b = samp ? (row - MP) >> 5 : row >> 12, t = samp ? (row - MP) & 31 : row & 4095;
    float acc[2][8];
#pragma unroll
    for (int hh = 0; hh < 2; ++hh) load8f(conv_b + hh * 512 + 8 * lane, acc[hh]);
    for (int j = 0; j < CONVW; ++j) {
        const int tt = t - 30 + j;
        if (tt < 0 && !samp) continue;
#pragma unroll
        for (int hh = 0; hh < 2; ++hh) {
            const int c = hh * 512 + 8 * lane; float a[8], w[8];
            if (tt >= 0) { const bf16* zr = z + (size_t)(row - 30 + j) * INC + ZA + c; float x[8], g[8]; unpack8(*(const v4u*)zr, x); unpack8(*(const v4u*)(zr + CONVD), g);
#pragma unroll
                for (int i = 0; i < 8; ++i) a[i] = x[i] * pg8::sigm(g[i]);
            } else load8f(cache_conv + (((size_t)l * DBATCH + b) * 30 + (30 + tt)) * CONVD + c, a);
            load8f(conv_w + (size_t)j * CONVD + c, w);
#pragma unroll
            for (int i = 0; i < 8; ++i) acc[hh][i] += a[i] * w[i];
            if (j == CONVW - 1) {
                if (!samp && t >= SEQ - 30) store8f(out + O_CSP + (((size_t)l * PBATCH + b) * 30 + (t - (SEQ - 30))) * CONVD + c, a);
                if (samp && t >= 2) store8f(out + O_CSS + (((size_t)l * DBATCH + b) * 30 + (t - 2)) * CONVD + c, a);
            }
        }
    }
    float s = 0.f;
#pragma unroll
    for (int hh = 0; hh < 2; ++hh)
#pragma unroll
        for (int i = 0; i < 8; ++i) s += acc[hh][i];
    const float mean = wave_sum(s) * (1.f / CONVD); float q = 0.f;
#pragma unroll
    for (int hh = 0; hh < 2; ++hh)
#pragma unroll
        for (int i = 0; i < 8; ++i) { acc[hh][i] -= mean; q += acc[hh][i] * acc[hh][i]; }
    const float rstd = 1.0f / sqrtf(wave_sum(q) * (1.f / CONVD) + EPS);
#pragma unroll
    for (int hh = 0; hh < 2; ++hh) { const int c = hh * 512 + 8 * lane; float g[8], bb[8], y[8]; load8f(ln_g + c, g); load8f(ln_b + c, bb);
#pragma unroll
        for (int i = 0; i < 8; ++i) { const float v = acc[hh][i] * rstd * g[i] + bb[i]; y[i] = v * pg8::sigm(v); }
        *(v4u*)(ya + (size_t)row * CONVD + c) = pack8(y); }
}
__device__ __forceinline__ void gmlp_v_row(int l, int row, const bf16* z, const float* ln_g, const float* ln_b, bf16* vb, float* out, int lane) {
    float x[2][8]; float s = 0.f;
#pragma unroll
    for (int hh = 0; hh < 2; ++hh) { const int c = hh * 512 + 8 * lane; unpack8(*(const v4u*)(z + (size_t)row * INC + ZB + GMD + c), x[hh]);
#pragma unroll
        for (int i = 0; i < 8; ++i) { x[hh][i] = gelu_tanh(x[hh][i]); s += x[hh][i]; } }
    const float mean = wave_sum(s) * (1.f / GMD); float q = 0.f;
#pragma unroll
    for (int hh = 0; hh < 2; ++hh)
#pragma unroll
        for (int i = 0; i < 8; ++i) { x[hh][i] -= mean; q += x[hh][i] * x[hh][i]; }
    const float rstd = 1.0f / sqrtf(wave_sum(q) * (1.f / GMD) + EPS);
#pragma unroll
    for (int hh = 0; hh < 2; ++hh) { const int c = hh * 512 + 8 * lane; float g[8], bb[8], y[8]; load8f(ln_g + c, g); load8f(ln_b + c, bb);
#pragma unroll
        for (int i = 0; i < 8; ++i) y[i] = x[hh][i] * rstd * g[i] + bb[i];
        *(v4u*)(vb + (size_t)row * GMD + c) = pack8(y);
        if (row >= MP) store8f(out + O_GV + ((size_t)l * MS + (row - MP)) * GMD + c, y); }
}
__device__ __forceinline__ void gmlp_spatial_row(int row, const bf16* z, const bf16* vb, const float* ws, const float* bs, bf16* yb, int lane) {
    const bool samp = row >= MP; const int t = samp ? (row - MP) & 31 : row & 4095; const int tl = samp ? t : (t & 127); const int chunk0 = row - tl;
    float acc[2][8];
#pragma unroll
    for (int hh = 0; hh < 2; ++hh)
#pragma unroll
        for (int i = 0; i < 8; ++i) acc[hh][i] = 0.f;
    const int g0 = lane >> 4;
    for (int s = 0; s <= tl; ++s) {
#pragma unroll
        for (int hh = 0; hh < 2; ++hh) { const int c = hh * 512 + 8 * lane; const float w = ws[((size_t)(hh * 4 + g0) * 128 + tl) * 128 + s]; float v[8]; unpack8(*(const v4u*)(vb + (size_t)(chunk0 + s) * GMD + c), v);
#pragma unroll
            for (int i = 0; i < 8; ++i) acc[hh][i] += w * v[i]; }
    }
#pragma unroll
    for (int hh = 0; hh < 2; ++hh) { const int c = hh * 512 + 8 * lane; const float bias = bs[(hh * 4 + g0) * 128 + tl]; float u[8], y[8]; unpack8(*(const v4u*)(z + (size_t)row * INC + ZB + c), u);
#pragma unroll
        for (int i = 0; i < 8; ++i) y[i] = gelu_tanh(u[i]) * (acc[hh][i] + bias);
        *(v4u*)(yb + (size_t)row * GMD + c) = pack8(y); }
}
__device__ __forceinline__ void attn_task(int l, int row, int hh, const bf16* z, const float* ck, const float* cv, const float* tab, bf16* o, int lane) {
    const float scale = 0.08838834764831845f;
    const unsigned qw = *(const unsigned*)(z + (size_t)row * INC + ZQ + hh * HDIM + 2 * lane);
    const float q0 = pg8::bf_lo(qw) * scale, q1 = pg8::bf_hi(qw) * scale;
    float m = -3.0e38f, lsum = 0.f, o0 = 0.f, o1 = 0.f;
    const float* tb = tab + hh * 257;
    const int col = hh * HDIM + 2 * lane;
    if (row < MP) {
        const int b = row >> 12, t = row & 4095, n = t >> 6;
        int p0 = (n - 8) * 64; if (p0 < 0) p0 = 0; const int p1 = n * 64 + 64;
        for (int p = p0; p < p1; ++p) {
            const bf16* kr = z + (size_t)(b * SEQ + p) * INC;
            const unsigned kw = *(const unsigned*)(kr + ZK + col), vw = *(const unsigned*)(kr + ZV + col);
            float s = wave_sum(q0 * pg8::bf_lo(kw) + q1 * pg8::bf_hi(kw));
            int rel = t - p; rel = rel < -128 ? -128 : (rel > 128 ? 128 : rel);
            s += tb[rel + 128];
            const float mn = fmaxf(m, s), corr = __expf(m - mn), pe = __expf(s - mn);
            lsum = lsum * corr + pe; o0 = o0 * corr + pe * pg8::bf_lo(vw); o1 = o1 * corr + pe * pg8::bf_hi(vw); m = mn;
        }
    } else {
        const int b = (row - MP) >> 5, t = (row - MP) & 31;
        for (int kidx = 0; kidx < WCACHE + DSEQ; ++kidx) {
            float k0, k1, v0, v1;
            if (kidx < WCACHE) { const size_t off = ((((size_t)l * DBATCH + b) * WCACHE + kidx) * NHEAD + hh) * HDIM + 2 * lane;
                const f32x2g kk = *(const f32x2g*)(ck + off), vv = *(const f32x2g*)(cv + off); k0 = kk.x; k1 = kk.y; v0 = vv.x; v1 = vv.y; }
            else { const bf16* kr = z + (size_t)(MP + b * DSEQ + (kidx - WCACHE)) * INC; const unsigned kw = *(const unsigned*)(kr + ZK + col), vw = *(const unsigned*)(kr + ZV + col);
                k0 = pg8::bf_lo(kw); k1 = pg8::bf_hi(kw); v0 = pg8::bf_lo(vw); v1 = pg8::bf_hi(vw); }
            float s = wave_sum(q0 * k0 + q1 * k1);
            int rel = t + WCACHE - kidx; rel = rel < -128 ? -128 : (rel > 128 ? 128 : rel);
            s += tb[rel + 128];
            const float mn = fmaxf(m, s), corr = __expf(m - mn), pe = __expf(s - mn);
            lsum = lsum * corr + pe; o0 = o0 * corr + pe * v0; o1 = o1 * corr + pe * v1; m = mn;
        }
    }
    const float inv = 1.0f / lsum;
    *(unsigned*)(o + (size_t)row * ATD + col) = pk2(o0 * inv, o1 * inv);
}
__device__ __forceinline__ void kv_rows(int l, int row, const bf16* z, float* out, int lane) {
    const bool samp = row >= MP; size_t ko, vo;
    if (samp) { ko = O_KS + ((size_t)l * MS + (row - MP)) * ATD; vo = O_VS + ((size_t)l * MS + (row - MP)) * ATD; }
    else { const int b = row >> 12, t = row & 4095; if (t < SEQ - WCACHE) return; ko = O_KP + (((size_t)l * PBATCH + b) * WCACHE + (t - (SEQ - WCACHE))) * ATD; vo = O_VP + (((size_t)l * PBATCH + b) * WCACHE + (t - (SEQ - WCACHE))) * ATD; }
#pragma unroll
    for (int hh = 0; hh < 2; ++hh) { const int c = hh * 512 + 8 * lane; float f[8];
        unpack8(*(const v4u*)(z + (size_t)row * INC + ZK + c), f); store8f(out + ko + c, f);
        unpack8(*(const v4u*)(z + (size_t)row * INC + ZV + c), f); store8f(out + vo + c, f); }
}
struct Args { const float* in[29]; float* out; unsigned char* ws; int ph_lo, ph_hi; };
constexpr int PH_PER_LAYER = 11, N_PHASES = 1 + DEPTH * PH_PER_LAYER + 1;

typedef const __attribute__((address_space(4))) Args* KArgs;
#define PHASE_ENTER() KArgs ap = (KArgs)__builtin_amdgcn_kernarg_segment_ptr(); asm volatile("" : "+s"(ap)); \
    int tid = threadIdx.x; asm volatile("" : "+v"(tid)); \
    const int lane = tid & 63, wave = __builtin_amdgcn_readfirstlane(tid >> 6); \
    const int G = gridDim.x; const int vcu = (G % 8 == 0) ? ((int)blockIdx.x % 8) * (G / 8) + (int)blockIdx.x / 8 : (int)blockIdx.x; \
    const int gw = vcu * NWAVES + wave, NGW = G * NWAVES; unsigned char* const ws = ap->ws; float* const out = ap->out; \
    (void)lane; (void)gw; (void)NGW; (void)out; (void)ws
#define WSP(T, off) ((T*)(ws + (off)))

__global__ void __launch_bounds__(NWAVES * 64, 2) enc_fwd(Args args) {
    extern __shared__ __attribute__((aligned(16))) unsigned char lds[];
    LAS unsigned char* const L = (LAS unsigned char*)lds;
    { const int tid0 = threadIdx.x;
      for (int u = tid0; u < (LDS_BYTES - LDSCTL_OFF) / 4; u += NWAVES * 64) ((LAS unsigned*)(L + LDSCTL_OFF))[u] = 0u; }
    __syncthreads();
    if (!MK_PER_PHASE) { (void)xcd_barrier_post((unsigned*)((gu32*)(args.ws + WS_CTL) + CW_BAR), (volatile LAS unsigned*)(L + MISC_OFF) + 8); }
    const int lo = args.ph_lo, hi = args.ph_hi;
#define IN(k) (lo <= (k) && (k) < hi)
#define SEAM(k) do { if (IN((k) + 1)) { if (MK_PER_PHASE) { if (threadIdx.x == 0) __hip_atomic_store((gu32*)ws, 0xBADBA0u, RLX_AGENT); } \
        else { XcdBarrier bar_; bar_.bar = (unsigned*)((gu32*)(ws + WS_CTL) + CW_BAR); bar_.x = xb_xcc_id(); bar_.st = (volatile LAS unsigned*)(L + MISC_OFF) + 8; xcd_barrier(bar_); } } } while (0)

    if (IN(0)) {
        PHASE_ENTER();
        LAS float* scr = (LAS float*)(L + RING_OFF + wave * 16384);
        constexpr int I_IN = (DM / 64) * (INC / 32), I_BR = (CONVD / 64) * (DM / 32), I_O = (DM / 64) * (DM / 32), I_F1 = (DM / 64) * (DFF / 32), I_F2 = (DFF / 64) * (DM / 32), I_PG = I_O, I_PP = (PLED / 64) * (DM / 32);
        constexpr int I_LAYER = I_IN + 3 * I_BR + I_O + I_F1 + I_F2 + I_PG + I_PP;
        for (int it = gw; it < DEPTH * I_LAYER; it += NGW) {
            const int l = it / I_LAYER; int r = it % I_LAYER; unsigned char* wl = ws + WS_WT + (size_t)l * WT_LAYER;
            if (r < I_IN) { p0_transpose_item(ap->in[8] + (size_t)l * DM * INC, DM, INC, (bf16*)(wl + WT_IN), scr, r, lane); continue; } r -= I_IN;
            if (r < I_BR) { p0_transpose_item(ap->in[13] + (size_t)l * CONVD * DM, CONVD, DM, (bf16*)(wl + WT_A), scr, r, lane); continue; } r -= I_BR;
            if (r < I_BR) { p0_transpose_item(ap->in[18] + (size_t)l * GMD * DM, GMD, DM, (bf16*)(wl + WT_B), scr, r, lane); continue; } r -= I_BR;
            if (r < I_BR) { p0_transpose_item(ap->in[20] + (size_t)l * ATD * DM, ATD, DM, (bf16*)(wl + WT_C), scr, r, lane); continue; } r -= I_BR;
            if (r < I_O) { p0_transpose_item(ap->in[21] + (size_t)l * DM * DM, DM, DM, (bf16*)(wl + WT_O), scr, r, lane); continue; } r -= I_O;
            if (r < I_F1) { p0_transpose_item(ap->in[23] + (size_t)l * DM * DFF, DM, DFF, (bf16*)(wl + WT_F1), scr, r, lane); continue; } r -= I_F1;
            if (r < I_F2) { p0_transpose_item(ap->in[24] + (size_t)l * DFF * DM, DFF, DM, (bf16*)(wl + WT_F2), scr, r, lane); continue; } r -= I_F2;
            if (r < I_PG) { p0_transpose_item(ap->in[26] + (size_t)l * DM * DM, DM, DM, (bf16*)(wl + WT_PG), scr, r, lane); continue; } r -= I_PG;
            p0_transpose_item(ap->in[27] + (size_t)l * PLED * DM, PLED, DM, (bf16*)(wl + WT_PP), scr, r, lane);
        }
        float* const H = WSP(float, WS_H); bf16* const PLEB = WSP(bf16, WS_PLE);
        for (int row = gw; row < MTOK; row += NGW) {
            const float* src = row < MP ? ap->in[0] + (size_t)row * DM : ap->in[1] + (size_t)(row - MP) * DM;
            const f32x4* s4 = (const f32x4*)src + lane; f32x4* d4 = (f32x4*)(H + (size_t)row * DM) + lane;
#pragma unroll
            for (int j = 0; j < 8; ++j) d4[64 * j] = s4[64 * j];
        }
        for (int r = gw; r < DEPTH * MTOK; r += NGW) {
            const int l = r / MTOK, row = r % MTOK;
            const float* src = row < MP ? ap->in[2] + ((size_t)l * MP + row) * PLED : ap->in[3] + ((size_t)l * MS + (row - MP)) * PLED;
            const f32x4 v = ((const f32x4*)src)[lane]; u32x2g w; w.x = pk2(v[0], v[1]); w.y = pk2(v[2], v[3]);
            ((u32x2g*)(PLEB + (size_t)r * PLED))[lane] = w;
        }
        SEAM(0);
    }

    for (int l = 0; l < DEPTH; ++l) {
        const int pb = 1 + l * PH_PER_LAYER;
#define WL(off) ((const bf16*)(ws + WS_WT + (size_t)l * WT_LAYER + (off)))
#define GEMM_CALL(EPI, Aptr, Bptr, NN, KK, ...) do { pg8::Gemm g_{Aptr, Bptr, MTOK, NN, KK}; pg8::StaticOrder S_; S_.init(MTOK, NN, (int)gridDim.x, (int)blockIdx.x); EPI E_{__VA_ARGS__}; \
        pg8::gemm_phase<EPI, pg8::StaticOrder, PG8_ALIGN, PG8_SP2>(L + RING_OFF, g_, S_, E_); } while (0)
        if (IN(pb + 0)) { PHASE_ENTER(); for (int row = gw; row < MTOK; row += NGW) rms_row_bf16(WSP(float, WS_H) + (size_t)row * DM, ap->in[7] + (size_t)l * DM, WSP(bf16, WS_XN) + (size_t)row * DM, lane); SEAM(pb + 0); }
        if (IN(pb + 1)) { PHASE_ENTER();
            GEMM_CALL(pg8::EpiBf16<0>, WSP(bf16, WS_XN), WL(WT_IN), INC, DM, WSP(bf16, WS_Z), INC);
            GEMM_CALL(pg8::EpiBf16<0>, WSP(bf16, WS_PLE) + (size_t)l * MTOK * PLED, WL(WT_PP), DM, PLED, WSP(bf16, WS_PP), DM);
            SEAM(pb + 1); }
        if (IN(pb + 2)) { PHASE_ENTER(); const bf16* const Z = WSP(bf16, WS_Z);
            for (int row = gw; row < MTOK; row += NGW) conv_row(l, row, Z, ap->in[4], ap->in[9] + (size_t)l * CONVW * CONVD, ap->in[10] + (size_t)l * CONVD, ap->in[11] + (size_t)l * CONVD, ap->in[12] + (size_t)l * CONVD, WSP(bf16, WS_YA), out, lane);
            for (int row = gw; row < MTOK; row += NGW) gmlp_v_row(l, row, Z, ap->in[14] + (size_t)l * GMD, ap->in[15] + (size_t)l * GMD, WSP(bf16, WS_V), out, lane);
            for (int row = gw; row < MTOK; row += NGW) kv_rows(l, row, Z, out, lane);
            for (int it = gw; it < MTOK * NHEAD; it += NGW) attn_task(l, it >> 3, it & 7, Z, ap->in[5], ap->in[6], ap->in[19] + (size_t)l * NHEAD * 257, WSP(bf16, WS_O), lane);
            SEAM(pb + 2); }
        if (IN(pb + 3)) { PHASE_ENTER(); for (int row = gw; row < MTOK; row += NGW) gmlp_spatial_row(row, WSP(bf16, WS_Z), WSP(bf16, WS_V), ap->in[16] + (size_t)l * 8 * 128 * 128, ap->in[17] + (size_t)l * 8 * 128, WSP(bf16, WS_YB), lane); SEAM(pb + 3); }
        if (IN(pb + 4)) { PHASE_ENTER();
            GEMM_CALL(pg8::EpiBranch<0>, WSP(bf16, WS_YA), WL(WT_A), DM, CONVD, WSP(bf16, WS_Z) + ZG, INC, WSP(float, WS_MG), WSP(bf16, WS_MERGED), DM);
            GEMM_CALL(pg8::EpiBranch<1>, WSP(bf16, WS_YB), WL(WT_B), DM, GMD, WSP(bf16, WS_Z) + ZG + DM, INC, WSP(float, WS_MG), WSP(bf16, WS_MERGED), DM);
            GEMM_CALL(pg8::EpiBranch<2>, WSP(bf16, WS_O), WL(WT_C), DM, ATD, WSP(bf16, WS_Z) + ZG + 2 * DM, INC, WSP(float, WS_MG), WSP(bf16, WS_MERGED), DM);
            SEAM(pb + 4); }
        if (IN(pb + 5)) { PHASE_ENTER(); GEMM_CALL(pg8::EpiResAdd, WSP(bf16, WS_MERGED), WL(WT_O), DM, DM, WSP(float, WS_H), DM); SEAM(pb + 5); }
        if (IN(pb + 6)) { PHASE_ENTER(); for (int row = gw; row < MTOK; row += NGW) rms_row_bf16(WSP(float, WS_H) + (size_t)row * DM, ap->in[22] + (size_t)l * DM, WSP(bf16, WS_XN) + (size_t)row * DM, lane); SEAM(pb + 6); }
        if (IN(pb + 7)) { PHASE_ENTER(); GEMM_CALL(pg8::EpiBf16<1>, WSP(bf16, WS_XN), WL(WT_F1), DFF, DM, WSP(bf16, WS_T), DFF); SEAM(pb + 7); }
        if (IN(pb + 8)) { PHASE_ENTER(); GEMM_CALL(pg8::EpiResAdd, WSP(bf16, WS_T), WL(WT_F2), DM, DFF, WSP(float, WS_H), DM); SEAM(pb + 8); }
        if (IN(pb + 9)) { PHASE_ENTER(); for (int row = gw; row < MTOK; row += NGW) rms_row_bf16(WSP(float, WS_H) + (size_t)row * DM, ap->in[25] + (size_t)l * DM, WSP(bf16, WS_XN) + (size_t)row * DM, lane); SEAM(pb + 9); }
        if (IN(pb + 10)) { PHASE_ENTER(); GEMM_CALL(pg8::EpiPle, WSP(bf16, WS_XN), WL(WT_PG), DM, DM, WSP(float, WS_H), WSP(bf16, WS_PP), DM); SEAM(pb + 10); }
    }
    if (IN(N_PHASES - 1)) { PHASE_ENTER(); for (int row = gw; row < MTOK; row += NGW) rms_row_f32(WSP(float, WS_H) + (size_t)row * DM, ap->in[28], out + (size_t)row * DM, lane); }
#undef IN
#undef SEAM
}

extern "C" void kernel_launch(void* const* d_in, const int* in_sizes, int n_in, void* d_out, int out_size, void* d_ws, size_t ws_size, hipStream_t stream) {
    static int grid = 0;
    if (grid == 0) {
        if (n_in != 29 || out_size != (int)O_END || ws_size < WS_END) { fprintf(stderr, "kernel_launch: unexpected shapes: n_in %d, out %d, ws %zu; nothing launched\n", n_in, out_size, ws_size); grid = -1; return; }
        int dev = 0, cus = 0, per_cu = 0;
        if (hipGetDevice(&dev) != hipSuccess || hipDeviceGetAttribute(&cus, hipDeviceAttributeMultiprocessorCount, dev) != hipSuccess) { fprintf(stderr, "kernel_launch: device query failed\n"); grid = -1; return; }
        if (hipFuncSetAttribute((const void*)enc_fwd, hipFuncAttributeMaxDynamicSharedMemorySize, LDS_BYTES) != hipSuccess) { fprintf(stderr, "kernel_launch: hipFuncSetAttribute failed\n"); grid = -1; return; }
        if (hipOccupancyMaxActiveBlocksPerMultiprocessor(&per_cu, (const void*)enc_fwd, NWAVES * 64, LDS_BYTES) != hipSuccess || per_cu < 1) { fprintf(stderr, "kernel_launch: occupancy query reports %d workgroups per CU\n", per_cu); }
        (void)hipGetLastError();
        grid = cus;
    }
    if (grid < 0) return;
    if (hipMemsetAsync((char*)d_ws + WS_CTL, 0, CTL_ZERO_BYTES, stream) != hipSuccess) { fprintf(stderr, "kernel_launch: memset failed\n"); return; }
    Args a{};
    for (int i = 0; i < 29; ++i) a.in[i] = (const float*)d_in[i];
    a.out = (float*)d_out; a.ws = (unsigned char*)d_ws;
#if MK_PER_PHASE
    for (int p = 0; p < N_PHASES; ++p) { a.ph_lo = p; a.ph_hi = p + 1; hipLaunchKernelGGL(enc_fwd, dim3(grid), dim3(NWAVES * 64), LDS_BYTES, stream, a); }
#else
    a.ph_lo = 0; a.ph_hi = N_PHASES;
    hipLaunchKernelGGL(enc_fwd, dim3(grid), dim3(NWAVES * 64), LDS_BYTES, stream, a);
#endif
    const hipError_t le = hipPeekAtLastError();
    if (le != hipSuccess) fprintf(stderr, "kernel_launch: launch failed: %s\n", hipGetErrorName(le));
}
```

```cpp
#include <hip/hip_runtime.h>
#include <cstdio>
#include <cstdint>
namespace pg8 {
#define PG8_LAS __attribute__((address_space(3)))
typedef unsigned short bf16_t;
typedef short bf16x8 __attribute__((ext_vector_type(8)));
typedef float f32x4 __attribute__((ext_vector_type(4)));
typedef unsigned u32x4 __attribute__((ext_vector_type(4)));
constexpr int BM = 256, BK = 64, HALF = 128, HTB = HALF * BK * 2  , STAGE_BYTES = 8 * HTB, NXCD = 8, WGM = 8;

__host__ __device__ __forceinline__ int lds_byte(int r, int c) { const int st = (r >> 4) * 2 + (c >> 5), rr = r & 15, cc = c & 31, ob = rr * 64 + cc * 2; return st * 1024 + (ob ^ (((ob >> 9) & 1) << 5)); }
__host__ __device__ __forceinline__ void stage_rc(int b, int& R, int& C) { const int st = b / 1024, sb = b % 1024, swz = sb ^ (((sb >> 9) & 1) << 5); R = (st >> 1) * 16 + swz / 64; C = (st & 1) * 32 + (swz % 64) / 2; }
__host__ __device__ __forceinline__ int perm32(int rho) { const int n = rho >> 4, i = rho & 15; return 8 * (i >> 2) + 4 * n + (i & 3); }

struct Unit { int pm, pn, k0, nt, ks, br, cont; };
struct Gemm { const bf16_t* A; const bf16_t* Bt; int M, N, K; size_t abr, bbr; int lda, ldb; };

__host__ __device__ __forceinline__ int permw52(int j) { const int h = j >= 26 ? 1 : 0, k = j - 26 * h; return k < 12 ? 28 + 12 * h + k : (k < 16 ? 4 * h + (k - 12) : 8 + 10 * h + (k - 16)); }
struct StaticOrder {
    int nM, nN, nwg, G, c, ntf, wperm;
    __host__ __device__ void init(int M, int N, int K, int G_, int c_, int wperm_ = 0) { nM = M / BM; nN = N / BM; nwg = nM * nN; G = G_; c = c_; ntf = K / BK; wperm = wperm_; }
    __host__ __device__ bool next(int i, Unit& u) const {
        const long L = (long)i * G + c; if (L >= nwg) return false;
        int wgid = (int)L; { const int q = nwg / NXCD, r = nwg % NXCD, xcd = wgid % NXCD, off = wgid / NXCD; wgid = (xcd < r ? xcd * (q + 1) : r * (q + 1) + (xcd - r) * q) + off; }
        const int nig = WGM * nN, gid = wgid / nig, fm = gid * WGM, gsz = (nM - fm) < WGM ? (nM - fm) : WGM;
        const int pn_ = (wgid % nig) / gsz; u.pm = fm + ((wgid % nig) % gsz); u.pn = wperm == 1 ? permw52(pn_) : (wperm == 2 ? (7 * pn_) % 52 : pn_);     u.k0 = 0; u.nt = ntf; u.ks = 0; u.br = 0; u.cont = 0; return true;
    }
    __device__ __forceinline__ void a_ready(const Unit&) const {}
    __device__ __forceinline__ void done(const Unit&) const {}
};
struct SplitOrder {
    StaticOrder P; int S, npt, part;
    __host__ __device__ void init(int Mp, int N, int K, int S_, int G_, int c_, int part_ = 0) { P.init(Mp, N, K, G_, c_); S = S_; npt = P.nwg; part = part_; }
    __host__ __device__ __forceinline__ bool next(int i, Unit& u) const {
        const long L = (long)i * P.G + P.c;
        const bool prompt = part != 2 && L < npt; const int j = part == 2 ? (int)L : (int)(L - npt);
        if (!prompt && (part == 1 || j >= 2 * P.nN * S)) return false;
        int pm, pn, k0 = 0, nt = P.ntf, ks = 0;
        if (prompt) { int wgid = (int)L; { const int q = P.nwg / NXCD, r = P.nwg % NXCD, xcd = wgid % NXCD, off = wgid / NXCD; wgid = (xcd < r ? xcd * (q + 1) : r * (q + 1) + (xcd - r) * q) + off; }
            const int nig = WGM * P.nN, gid = wgid / nig, fm = gid * WGM, gsz = (P.nM - fm) < WGM ? (P.nM - fm) : WGM;
            pm = fm + ((wgid % nig) % gsz); pn = (wgid % nig) / gsz; }
        else { const int tile = j / S; ks = j - tile * S; pm = P.nM + tile / P.nN; pn = tile % P.nN; nt = P.ntf / S; k0 = ks * nt * BK; }
        u.pm = pm; u.pn = pn; u.k0 = k0; u.nt = nt; u.ks = ks; u.br = 0; u.cont = 0; return true;
    }
    __device__ __forceinline__ void a_ready(const Unit&) const {}
    __device__ __forceinline__ void done(const Unit&) const {}
};
struct BranchOrder {
    StaticOrder P; int SB;
    __host__ __device__ void init(int Mp, int N, int K, int SB_, int G_, int c_) { P.init(Mp, N, K, G_, c_); SB = SB_; }
    __host__ __device__ __forceinline__ bool next(int i, Unit& u) const {
        const int nP = P.c < P.nwg ? (P.nwg - 1 - P.c) / P.G + 1 : 0;
        int pm, pn, k0 = 0, nt = P.ntf, ks = 0, br, cont = 0;
        if (i < 3 * nP) { br = i % 3; cont = br < 2 ? 1 : 0; int wgid = (i / 3) * P.G + P.c;
            { const int q = P.nwg / NXCD, r = P.nwg % NXCD, xcd = wgid % NXCD, off = wgid / NXCD; wgid = (xcd < r ? xcd * (q + 1) : r * (q + 1) + (xcd - r) * q) + off; }
            const int nig = WGM * P.nN, gid = wgid / nig, fm = gid * WGM, gsz = (P.nM - fm) < WGM ? (P.nM - fm) : WGM;
            pm = fm + ((wgid % nig) % gsz); pn = (wgid % nig) / gsz; }
        else { const int j = (i - 3 * nP) * P.G + P.c; if (j >= 2 * P.nN * 3 * SB) return false;
            const int tile = j / (3 * SB), rem = j - tile * 3 * SB; br = rem / SB; const int sl = rem - br * SB;
            pm = P.nM + tile / P.nN; pn = tile % P.nN; nt = P.ntf / SB; k0 = sl * nt * BK; ks = br * SB + sl; }
        u.pm = pm; u.pn = pn; u.k0 = k0; u.nt = nt; u.ks = ks; u.br = br; u.cont = cont; return true;
    }
    __device__ __forceinline__ void a_ready(const Unit&) const {}
    __device__ __forceinline__ void done(const Unit&) const {}
};
struct SliceOrder {
    int nN, ntiles, S, G, c, ntf;
    __host__ __device__ void init(int M, int N, int K, int S_, int G_, int c_) { nN = N / BM; ntiles = (M / BM) * nN; S = S_; G = G_; c = c_; ntf = K / BK; }
    __host__ __device__ __forceinline__ bool next(int i, Unit& u) const {
        const long j = (long)i * G + c; if (j >= (long)ntiles * S) return false;
        const int tile = (int)(j / S), ks = (int)(j - (long)tile * S), nt = ntf / S;
        u.pm = tile / nN; u.pn = tile % nN; u.k0 = ks * nt * BK; u.nt = nt; u.ks = ks; u.br = 0; u.cont = 0; return true;
    }
    __device__ __forceinline__ void a_ready(const Unit&) const {}
    __device__ __forceinline__ void done(const Unit&) const {}
};
__device__ __forceinline__ unsigned cvt_pk_bf16(float lo, float hi) { unsigned r; asm volatile("v_cvt_pk_bf16_f32 %0, %1, %2" : "=v"(r) : "v"(lo), "v"(hi)); return r; }
typedef unsigned u32x2 __attribute__((ext_vector_type(2)));
__device__ __forceinline__ float bf_lo(unsigned w) { return __uint_as_float(w << 16); }
__device__ __forceinline__ float bf_hi(unsigned w) { return __uint_as_float(w & 0xffff0000u); }
__device__ __forceinline__ float sigm(float x) { return __builtin_amdgcn_rcpf(1.0f + __expf(-x)); }

constexpr float NRM_INV_D = 1.0f / 2048.0f, NRM_EPS = 1e-6f;
__device__ __forceinline__ float rstd_of(float ss) { return __builtin_amdgcn_rsqf(ss * NRM_INV_D + NRM_EPS); }
typedef unsigned long long ssq_t;
constexpr float SSQ_SCALE = 16777216.0f, SSQ_INV = 1.0f / 16777216.0f;
__device__ __forceinline__ ssq_t ssq_of(float ss) { return (ssq_t)(ss * SSQ_SCALE); }
__device__ __forceinline__ float ss_load(const ssq_t* p) { return (float)__hip_atomic_load(p, __ATOMIC_RELAXED, __HIP_MEMORY_SCOPE_AGENT) * SSQ_INV; }
__device__ __forceinline__ float ssq_to_f(ssq_t v) { return (float)(unsigned)(v >> 32) * 256.0f + (float)(unsigned)v * SSQ_INV; }
__device__ __forceinline__ float ss_load_after_barrier(const ssq_t* p) { return ssq_to_f(*p); }
__device__ __forceinline__ void ss_store(ssq_t* p, float v) { __hip_atomic_store(p, ssq_of(v), __ATOMIC_RELAXED, __HIP_MEMORY_SCOPE_AGENT); }
__device__ __forceinline__ void ss_add(ssq_t* p, float v) { (void)__hip_atomic_fetch_add(p, ssq_of(v), __ATOMIC_RELAXED, __HIP_MEMORY_SCOPE_AGENT); }
template <int ACT> struct EpiBf16 {
    static constexpr bool PERM = true, AFTER_DRAIN = false;
    bf16_t* O; int ldc; const ssq_t* SS;
    __device__ __forceinline__ void operator()(const f32x4 (&acc)[2][2][4][2], const Unit& u, int wr, int wc, int fr, int fq) const {
        const int row0 = u.pm * BM + wr * 64 + fr, col0 = u.pn * BM + wc * 32 + 8 * fq;
        float rs[2][4];
        if (SS) { ssq_t q_[2][4];
#pragma unroll
            for (int ai = 0; ai < 2; ++ai)
#pragma unroll
                for (int m = 0; m < 4; ++m) q_[ai][m] = SS[row0 + ai * HALF + m * 16];
#pragma unroll
            for (int ai = 0; ai < 2; ++ai)
#pragma unroll
                for (int m = 0; m < 4; ++m) rs[ai][m] = rstd_of(ssq_to_f(q_[ai][m]));
        } else {
#pragma unroll
            for (int ai = 0; ai < 2; ++ai)
#pragma unroll
                for (int m = 0; m < 4; ++m) rs[ai][m] = 1.0f; }
#pragma unroll
        for (int ai = 0; ai < 2; ++ai)
#pragma unroll
            for (int m = 0; m < 4; ++m) { bf16_t* rowp = O + (size_t)(row0 + ai * HALF + m * 16) * ldc + col0;
#pragma unroll
                for (int bj = 0; bj < 2; ++bj) { f32x4 v0 = acc[ai][bj][m][0] * rs[ai][m], v1 = acc[ai][bj][m][1] * rs[ai][m];
                    if (ACT == 1) {
#pragma unroll
                        for (int j = 0; j < 4; ++j) { const float a = fmaxf(v0[j], 0.f), b = fmaxf(v1[j], 0.f); v0[j] = a * a; v1[j] = b * b; } }
                    u32x4 w; w.x = cvt_pk_bf16(v0[0], v0[1]); w.y = cvt_pk_bf16(v0[2], v0[3]); w.z = cvt_pk_bf16(v1[0], v1[1]); w.w = cvt_pk_bf16(v1[2], v1[3]);
                    *(u32x4*)(rowp + bj * HALF) = w; } }
    }
};
struct EpiZ {
    static constexpr bool PERM = true, AFTER_DRAIN = false;
    bf16_t* O; int ldc; const ssq_t* SS; unsigned char* G8; int ldg, gate_pn, glu_pn;
    __device__ __forceinline__ void operator()(const f32x4 (&acc)[2][2][4][2], const Unit& u, int wr, int wc, int fr, int fq) const {
        const int row0 = u.pm * BM + wr * 64 + fr, col0 = u.pn * BM + wc * 32 + 8 * fq;
        float rs[2][4]; ssq_t q_[2][4];
#pragma unroll
        for (int ai = 0; ai < 2; ++ai)
#pragma unroll
            for (int m = 0; m < 4; ++m) q_[ai][m] = SS[row0 + ai * HALF + m * 16];
#pragma unroll
        for (int ai = 0; ai < 2; ++ai)
#pragma unroll
            for (int m = 0; m < 4; ++m) rs[ai][m] = rstd_of(ssq_to_f(q_[ai][m]));
        if (u.pn < glu_pn) {
#pragma unroll
            for (int ai = 0; ai < 2; ++ai)
#pragma unroll
                for (int m = 0; m < 4; ++m) { bf16_t* rowp = O + (size_t)(row0 + ai * HALF + m * 16) * ldc + (col0 >> 1);
#pragma unroll
                    for (int bj = 0; bj < 2; ++bj) { const f32x4 x = acc[ai][bj][m][0] * rs[ai][m], g = acc[ai][bj][m][1] * rs[ai][m];
                        u32x2 w; w.x = cvt_pk_bf16(x[0] * sigm(g[0]), x[1] * sigm(g[1])); w.y = cvt_pk_bf16(x[2] * sigm(g[2]), x[3] * sigm(g[3]));
                        *(u32x2*)(rowp + bj * (HALF / 2)) = w; } }
        } else if (u.pn < gate_pn) { const int zc0 = col0 - glu_pn * (BM / 2);
#pragma unroll
            for (int ai = 0; ai < 2; ++ai)
#pragma unroll
                for (int m = 0; m < 4; ++m) { bf16_t* rowp = O + (size_t)(row0 + ai * HALF + m * 16) * ldc + zc0;
#pragma unroll
                    for (int bj = 0; bj < 2; ++bj) { const f32x4 v0 = acc[ai][bj][m][0] * rs[ai][m], v1 = acc[ai][bj][m][1] * rs[ai][m];
                        u32x4 w; w.x = cvt_pk_bf16(v0[0], v0[1]); w.y = cvt_pk_bf16(v0[2], v0[3]); w.z = cvt_pk_bf16(v1[0], v1[1]); w.w = cvt_pk_bf16(v1[2], v1[3]);
                        *(u32x4*)(rowp + bj * HALF) = w; } }
        } else { const int gc0 = col0 - gate_pn * BM;
#pragma unroll
            for (int ai = 0; ai < 2; ++ai)
#pragma unroll
                for (int m = 0; m < 4; ++m) { unsigned char* rowp = G8 + (size_t)(row0 + ai * HALF + m * 16) * ldg + gc0;
#pragma unroll
                    for (int bj = 0; bj < 2; ++bj) { u32x2 w; w.x = 0u; w.y = 0u;
                        const float rsl_ = rs[ai][m] * -1.4426950408889634f;
                        f32x4 e0 = acc[ai][bj][m][0] * rsl_, e1 = acc[ai][bj][m][1] * rsl_;
#pragma unroll
                        for (int j = 0; j < 4; ++j) { e0[j] = __builtin_amdgcn_exp2f(e0[j]); e1[j] = __builtin_amdgcn_exp2f(e1[j]); }
                        e0 = e0 + 1.0f; e1 = e1 + 1.0f;
#pragma unroll
                        for (int j = 0; j < 4; ++j) { e0[j] = __builtin_amdgcn_rcpf(e0[j]); e1[j] = __builtin_amdgcn_rcpf(e1[j]); }
                        e0 = e0 * 255.0f + 0.5f; e1 = e1 * 255.0f + 0.5f;
                        w.x = __builtin_amdgcn_cvt_pk_u8_f32(fmaxf(e0[0], 1.0f), 0, w.x); w.x = __builtin_amdgcn_cvt_pk_u8_f32(fmaxf(e0[1], 1.0f), 1, w.x);
                        w.x = __builtin_amdgcn_cvt_pk_u8_f32(fmaxf(e0[2], 1.0f), 2, w.x); w.x = __builtin_amdgcn_cvt_pk_u8_f32(fmaxf(e0[3], 1.0f), 3, w.x);
                        w.y = __builtin_amdgcn_cvt_pk_u8_f32(fmaxf(e1[0], 1.0f), 0, w.y); w.y = __builtin_amdgcn_cvt_pk_u8_f32(fmaxf(e1[1], 1.0f), 1, w.y);
                        w.y = __builtin_amdgcn_cvt_pk_u8_f32(fmaxf(e1[2], 1.0f), 2, w.y); w.y = __builtin_amdgcn_cvt_pk_u8_f32(fmaxf(e1[3], 1.0f), 3, w.y);
                        *(u32x2*)(rowp + bj * HALF) = w; } }
        }
    }
};
struct EpiResAdd {
    static constexpr bool PERM = false, AFTER_DRAIN = false;
    float* H; int ldc;
    __device__ __forceinline__ void operator()(const f32x4 (&acc)[2][2][4][2], const Unit& u, int wr, int wc, int fr, int fq) const {
        const int row0 = u.pm * BM + wr * 64 + fr, col0 = u.pn * BM + wc * 32 + 4 * fq;
#pragma unroll
        for (int ai = 0; ai < 2; ++ai)
#pragma unroll
            for (int m = 0; m < 4; ++m) { float* rowp = H + (size_t)(row0 + ai * HALF + m * 16) * ldc + col0;
#pragma unroll
                for (int bj = 0; bj < 2; ++bj)
#pragma unroll
                    for (int n = 0; n < 2; ++n) { float* p = rowp + bj * HALF + n * 16; const f32x4 b = *(const f32x4*)p; *(f32x4*)p = b + acc[ai][bj][m][n]; }
                if (m & 1) asm volatile("" ::: "memory"); }
    }
};
template <int MODE> struct EpiBranch {
    static constexpr bool PERM = false, AFTER_DRAIN = false;
    const bf16_t* Zg; int ldz; float* MG; bf16_t* OUT; int ldc;
    __device__ __forceinline__ void operator()(const f32x4 (&acc)[2][2][4][2], const Unit& u, int wr, int wc, int fr, int fq) const {
        const int row0 = u.pm * BM + wr * 64 + fr, col0 = u.pn * BM + wc * 32 + 4 * fq;
#pragma unroll
        for (int ai = 0; ai < 2; ++ai)
#pragma unroll
            for (int m = 0; m < 4; ++m) { const size_t r = (size_t)(row0 + ai * HALF + m * 16);
#pragma unroll
                for (int bj = 0; bj < 2; ++bj)
#pragma unroll
                    for (int n = 0; n < 2; ++n) { const int c = col0 + bj * HALF + n * 16;
                        const u32x2 gw = *(const u32x2*)(Zg + r * ldz + c);
                        f32x4 g; g[0] = sigm(bf_lo(gw.x)); g[1] = sigm(bf_hi(gw.x)); g[2] = sigm(bf_lo(gw.y)); g[3] = sigm(bf_hi(gw.y));
                        f32x4 v = g * acc[ai][bj][m][n];
                        float* mp = MG + r * ldc + c;
                        if (MODE == 0) { *(f32x4*)mp = v; }
                        else if (MODE == 1) { const f32x4 b = *(const f32x4*)mp; *(f32x4*)mp = b + v; }
                        else { const f32x4 b = *(const f32x4*)mp; v = b + v; u32x2 w; w.x = cvt_pk_bf16(v[0], v[1]); w.y = cvt_pk_bf16(v[2], v[3]); *(u32x2*)(OUT + r * ldc + c) = w; } }
                if (m & 1) asm volatile("" ::: "memory"); }
    }
};
struct EpiPle {
    static constexpr bool PERM = false, AFTER_DRAIN = false;
    float* H; const bf16_t* PP; int ldc;
    __device__ __forceinline__ void operator()(const f32x4 (&acc)[2][2][4][2], const Unit& u, int wr, int wc, int fr, int fq) const {
        const int row0 = u.pm * BM + wr * 64 + fr, col0 = u.pn * BM + wc * 32 + 4 * fq;
#pragma unroll
        for (int ai = 0; ai < 2; ++ai)
#pragma unroll
            for (int m = 0; m < 4; ++m) { const size_t r = (size_t)(row0 + ai * HALF + m * 16);
#pragma unroll
                for (int bj = 0; bj < 2; ++bj)
#pragma unroll
                    for (int n = 0; n < 2; ++n) { const int c = col0 + bj * HALF + n * 16;
                        const u32x2 pw = *(const u32x2*)(PP + r * ldc + c);
                        f32x4 pv; pv[0] = bf_lo(pw.x); pv[1] = bf_hi(pw.x); pv[2] = bf_lo(pw.y); pv[3] = bf_hi(pw.y);
                        const f32x4 a = acc[ai][bj][m][n]; f32x4 g; g[0] = sigm(a[0]); g[1] = sigm(a[1]); g[2] = sigm(a[2]); g[3] = sigm(a[3]);
                        float* p = H + r * ldc + c; const f32x4 b = *(const f32x4*)p; *(f32x4*)p = b + g * pv; }
                if (m & 1) asm volatile("" ::: "memory"); }
    }
};

template <int TAG> struct EpiResAddSplitT {
    static constexpr bool PERM = false, AFTER_DRAIN = false;
    float* H; int ldc; float* SLAB; int PMT; bf16_t* HB; ssq_t* SSo;
    __device__ __forceinline__ void operator()(const f32x4 (&acc)[2][2][4][2], const Unit& u, int wr, int wc, int fr, int fq) const {
        const int col0 = u.pn * BM + wc * 32 + 4 * fq;
        if (u.pm < PMT) { const int row0 = u.pm * BM + wr * 64 + fr;
#pragma unroll
            for (int ai = 0; ai < 2; ++ai)
#pragma unroll
                for (int m = 0; m < 4; ++m) { const size_t ro = (size_t)(row0 + ai * HALF + m * 16) * ldc + col0; float* rowp = H + ro; float ss = 0.f;
#pragma unroll
                    for (int bj = 0; bj < 2; ++bj)
#pragma unroll
                        for (int n = 0; n < 2; ++n) { float* p = rowp + bj * HALF + n * 16; const f32x4 b = *(const f32x4*)p; const f32x4 hn = b + acc[ai][bj][m][n]; *(f32x4*)p = hn;
                            u32x2 w; w.x = cvt_pk_bf16(hn[0], hn[1]); w.y = cvt_pk_bf16(hn[2], hn[3]); *(u32x2*)(HB + ro + bj * HALF + n * 16) = w;
                            ss += (hn[0] * hn[0] + hn[1] * hn[1]) + (hn[2] * hn[2] + hn[3] * hn[3]); }
                    { const int ln_ = fq * 16 + fr; ss += __builtin_bit_cast(float, __builtin_amdgcn_ds_bpermute((ln_ ^ 16) << 2, __builtin_bit_cast(int, ss))); ss += __builtin_bit_cast(float, __builtin_amdgcn_ds_bpermute((ln_ ^ 32) << 2, __builtin_bit_cast(int, ss))); }
                    if (fq == 0) ss_add(SSo + row0 + ai * HALF + m * 16, ss);
                    if (m & 1) asm volatile("" ::: "memory"); }
        } else { float* base = SLAB + ((size_t)u.ks * (2 * BM) + (size_t)(u.pm - PMT) * BM + wr * 64 + fr) * ldc + col0;
#pragma unroll
            for (int ai = 0; ai < 2; ++ai)
#pragma unroll
                for (int m = 0; m < 4; ++m) { float* rowp = base + (size_t)(ai * HALF + m * 16) * ldc;
#pragma unroll
                    for (int bj = 0; bj < 2; ++bj)
#pragma unroll
                        for (int n = 0; n < 2; ++n) *(f32x4*)(rowp + bj * HALF + n * 16) = acc[ai][bj][m][n]; }
        }
    }
};
typedef EpiResAddSplitT<0> EpiResAddSplit;
struct EpiPleSplit {
    static constexpr bool PERM = false, AFTER_DRAIN = false;
    float* H; const bf16_t* PP; int ldc; float* SLAB; int PMT; const ssq_t* SSi; bf16_t* HB; ssq_t* SSo;
    __device__ __forceinline__ void operator()(const f32x4 (&acc)[2][2][4][2], const Unit& u, int wr, int wc, int fr, int fq) const {
        const int col0 = u.pn * BM + wc * 32 + 4 * fq;
        if (u.pm < PMT) { const int row0 = u.pm * BM + wr * 64 + fr; ssq_t q_[2][4];
#pragma unroll
            for (int ai = 0; ai < 2; ++ai)
#pragma unroll
                for (int m = 0; m < 4; ++m) q_[ai][m] = SSi[row0 + ai * HALF + m * 16];
#pragma unroll
            for (int ai = 0; ai < 2; ++ai)
#pragma unroll
                for (int m = 0; m < 4; ++m) { const size_t r = (size_t)(row0 + ai * HALF + m * 16); const float rsi = rstd_of(ssq_to_f(q_[ai][m])); float ss = 0.f;
#pragma unroll
                    for (int bj = 0; bj < 2; ++bj)
#pragma unroll
                        for (int n = 0; n < 2; ++n) { const int c = col0 + bj * HALF + n * 16;
                            const u32x2 pw = *(const u32x2*)(PP + r * ldc + c);
                            f32x4 pv; pv[0] = bf_lo(pw.x); pv[1] = bf_hi(pw.x); pv[2] = bf_lo(pw.y); pv[3] = bf_hi(pw.y);
                            const f32x4 a = acc[ai][bj][m][n] * rsi; f32x4 g; g[0] = sigm(a[0]); g[1] = sigm(a[1]); g[2] = sigm(a[2]); g[3] = sigm(a[3]);
                            float* p = H + r * ldc + c; const f32x4 b = *(const f32x4*)p; const f32x4 hn = b + g * pv; *(f32x4*)p = hn;
                            u32x2 w; w.x = cvt_pk_bf16(hn[0], hn[1]); w.y = cvt_pk_bf16(hn[2], hn[3]); *(u32x2*)(HB + r * ldc + c) = w;
                            ss += (hn[0] * hn[0] + hn[1] * hn[1]) + (hn[2] * hn[2] + hn[3] * hn[3]); }
                    { const int ln_ = fq * 16 + fr; ss += __builtin_bit_cast(float, __builtin_amdgcn_ds_bpermute((ln_ ^ 16) << 2, __builtin_bit_cast(int, ss))); ss += __builtin_bit_cast(float, __builtin_amdgcn_ds_bpermute((ln_ ^ 32) << 2, __builtin_bit_cast(int, ss))); }
                    if (fq == 0) ss_add(SSo + r, ss);
                    if (m & 1) asm volatile("" ::: "memory"); }
        } else { float* base = SLAB + ((size_t)u.ks * (2 * BM) + (size_t)(u.pm - PMT) * BM + wr * 64 + fr) * ldc + col0;
#pragma unroll
            for (int ai = 0; ai < 2; ++ai)
#pragma unroll
                for (int m = 0; m < 4; ++m) { float* rowp = base + (size_t)(ai * HALF + m * 16) * ldc;
#pragma unroll
                    for (int bj = 0; bj < 2; ++bj)
#pragma unroll
                        for (int n = 0; n < 2; ++n) *(f32x4*)(rowp + bj * HALF + n * 16) = acc[ai][bj][m][n]; }
        }
    }
};

struct EpiBranchFused {
    static constexpr bool PERM = true, AFTER_DRAIN = false;
    const unsigned char* G8; int ldg; bf16_t* OUT; int ldc; bf16_t* SLAB; int PMT;
    static __device__ __forceinline__ void gates8w(const u32x2 w, float (&g)[8]) {

        g[0] = (float)(w.x & 0xffu); g[1] = (float)((w.x >> 8) & 0xffu); g[2] = (float)((w.x >> 16) & 0xffu); g[3] = (float)(w.x >> 24);
        g[4] = (float)(w.y & 0xffu); g[5] = (float)((w.y >> 8) & 0xffu); g[6] = (float)((w.y >> 16) & 0xffu); g[7] = (float)(w.y >> 24);
    }
    __device__ __forceinline__ void operator()(f32x4 (&acc)[2][2][4][2], const Unit& u, int wr, int wc, int fr, int fq) const {
        const int row0 = u.pm * BM + wr * 64 + fr, col0 = u.pn * BM + wc * 32 + 8 * fq;
        const bool prompt = u.pm < PMT; const bool ratio = prompt && u.br < 2;
        u32x2 gaq[2][4][2], gbq[2][4][2];
        if (ratio) {
#pragma unroll
        for (int ai = 0; ai < 2; ++ai)
#pragma unroll
            for (int m = 0; m < 4; ++m)
#pragma unroll
                for (int bj = 0; bj < 2; ++bj) { const unsigned char* gp = G8 + (size_t)(row0 + ai * HALF + m * 16) * ldg + (size_t)u.br * 2048 + col0 + bj * HALF;
                    gaq[ai][m][bj] = *(const u32x2*)gp; gbq[ai][m][bj] = *(const u32x2*)(gp + 2048); }
        } else {
#pragma unroll
        for (int ai = 0; ai < 2; ++ai)
#pragma unroll
            for (int m = 0; m < 4; ++m)
#pragma unroll
                for (int bj = 0; bj < 2; ++bj) { const unsigned char* gp = G8 + (size_t)(row0 + ai * HALF + m * 16) * ldg + (size_t)u.br * 2048 + col0 + bj * HALF;
                    gaq[ai][m][bj] = *(const u32x2*)gp; gbq[ai][m][bj] = (u32x2){0x01010101u, 0x01010101u}; }
        }
#pragma unroll
        for (int ai = 0; ai < 2; ++ai) {
#pragma unroll
            for (int m = 0; m < 4; ++m) { const size_t r = (size_t)(row0 + ai * HALF + m * 16);
#pragma unroll
                for (int bj = 0; bj < 2; ++bj) { const int c = col0 + bj * HALF;
                    float ga[8]; gates8w(gaq[ai][m][bj], ga); f32x4& v0 = acc[ai][bj][m][0]; f32x4& v1 = acc[ai][bj][m][1];
                    if (ratio) { float gb[8]; gates8w(gbq[ai][m][bj], gb);
#pragma unroll
                        for (int j = 0; j < 4; ++j) { v0[j] *= ga[j] * __builtin_amdgcn_rcpf(gb[j]); v1[j] *= ga[4 + j] * __builtin_amdgcn_rcpf(gb[4 + j]); }
                    } else { f32x4 o0, o1;
#pragma unroll
                        for (int j = 0; j < 4; ++j) { o0[j] = v0[j] * (ga[j] * (1.0f / 255.0f)); o1[j] = v1[j] * (ga[4 + j] * (1.0f / 255.0f)); }
                        if (prompt) { u32x4 w; w.x = cvt_pk_bf16(o0[0], o0[1]); w.y = cvt_pk_bf16(o0[2], o0[3]); w.z = cvt_pk_bf16(o1[0], o1[1]); w.w = cvt_pk_bf16(o1[2], o1[3]); *(u32x4*)(OUT + r * ldc + c) = w; }
                        else { bf16_t* sp = SLAB + ((size_t)u.ks * (2 * BM) + (r - (size_t)PMT * BM)) * ldc + c; u32x4 w; w.x = cvt_pk_bf16(o0[0], o0[1]); w.y = cvt_pk_bf16(o0[2], o0[3]); w.z = cvt_pk_bf16(o1[0], o1[1]); w.w = cvt_pk_bf16(o1[2], o1[3]); *(u32x4*)sp = w; } } }
                if (m & 1) asm volatile("" ::: "memory"); } }
    }
};

struct EpiResBf16Split {
    static constexpr bool PERM = true, AFTER_DRAIN = false;
    const bf16_t* Hin; bf16_t* Hout; int ldc; bf16_t* SLAB; int PMT; ssq_t* SSo;
    __device__ __forceinline__ void operator()(const f32x4 (&acc)[2][2][4][2], const Unit& u, int wr, int wc, int fr, int fq) const {
        const int col0 = u.pn * BM + wc * 32 + 8 * fq;
        if (u.pm < PMT) { const int row0 = u.pm * BM + wr * 64 + fr;
            u32x4 hq[2][4][2];
#pragma unroll
            for (int ai = 0; ai < 2; ++ai)
#pragma unroll
                for (int m = 0; m < 4; ++m)
#pragma unroll
                    for (int bj = 0; bj < 2; ++bj) hq[ai][m][bj] = *(const u32x4*)(Hin + (size_t)(row0 + ai * HALF + m * 16) * ldc + col0 + bj * HALF);
#pragma unroll
            for (int ai = 0; ai < 2; ++ai) {
#pragma unroll
                for (int m = 0; m < 4; ++m) { const size_t ro = (size_t)(row0 + ai * HALF + m * 16) * ldc + col0; float ss = 0.f;
#pragma unroll
                    for (int bj = 0; bj < 2; ++bj) { const u32x4 hw = hq[ai][m][bj];
                        const f32x4 h0 = (f32x4){bf_lo(hw.x), bf_hi(hw.x), bf_lo(hw.y), bf_hi(hw.y)}, h1 = (f32x4){bf_lo(hw.z), bf_hi(hw.z), bf_lo(hw.w), bf_hi(hw.w)};
                        const f32x4 v0 = h0 + acc[ai][bj][m][0], v1 = h1 + acc[ai][bj][m][1];
                        u32x4 w; w.x = cvt_pk_bf16(v0[0], v0[1]); w.y = cvt_pk_bf16(v0[2], v0[3]); w.z = cvt_pk_bf16(v1[0], v1[1]); w.w = cvt_pk_bf16(v1[2], v1[3]);
                        *(u32x4*)(Hout + ro + bj * HALF) = w;
                        ss += ((v0[0] * v0[0] + v0[1] * v0[1]) + (v0[2] * v0[2] + v0[3] * v0[3])) + ((v1[0] * v1[0] + v1[1] * v1[1]) + (v1[2] * v1[2] + v1[3] * v1[3])); }
                    { const int ln_ = fq * 16 + fr; ss += __builtin_bit_cast(float, __builtin_amdgcn_ds_bpermute((ln_ ^ 16) << 2, __builtin_bit_cast(int, ss))); ss += __builtin_bit_cast(float, __builtin_amdgcn_ds_bpermute((ln_ ^ 32) << 2, __builtin_bit_cast(int, ss))); }
                    if (fq == 0) ss_add(SSo + row0 + ai * HALF + m * 16, ss);
                    if (m & 1) asm volatile("" ::: "memory"); } }
        } else { bf16_t* base = SLAB + ((size_t)u.ks * (2 * BM) + (size_t)(u.pm - PMT) * BM + wr * 64 + fr) * ldc + col0;
#pragma unroll
            for (int ai = 0; ai < 2; ++ai)
#pragma unroll
                for (int m = 0; m < 4; ++m) { bf16_t* rowp = base + (size_t)(ai * HALF + m * 16) * ldc;
#pragma unroll
                    for (int bj = 0; bj < 2; ++bj) { const f32x4 a0 = acc[ai][bj][m][0], a1 = acc[ai][bj][m][1]; u32x4 w; w.x = cvt_pk_bf16(a0[0], a0[1]); w.y = cvt_pk_bf16(a0[2], a0[3]); w.z = cvt_pk_bf16(a1[0], a1[1]); w.w = cvt_pk_bf16(a1[2], a1[3]); *(u32x4*)(rowp + bj * HALF) = w; } }
        }
    }
};
struct EpiPleBf16Split {
    static constexpr bool PERM = true, AFTER_DRAIN = false;
    const bf16_t* Hin; bf16_t* Hout; const bf16_t* PP; int ldc; bf16_t* SLAB; int PMT; const ssq_t* SSi; ssq_t* SSo;
    __device__ __forceinline__ void operator()(const f32x4 (&acc)[2][2][4][2], const Unit& u, int wr, int wc, int fr, int fq) const {
        const int col0 = u.pn * BM + wc * 32 + 8 * fq;
        if (u.pm < PMT) { const int row0 = u.pm * BM + wr * 64 + fr; ssq_t q_[2][4];
#pragma unroll
            for (int ai = 0; ai < 2; ++ai)
#pragma unroll
                for (int m = 0; m < 4; ++m) q_[ai][m] = SSi[row0 + ai * HALF + m * 16];
#pragma unroll
            for (int ai = 0; ai < 2; ++ai) {
                u32x4 hq[4][2], pq[4][2];
#pragma unroll
                for (int m = 0; m < 4; ++m) {
                  if ((m & 1) == 0) {
#pragma unroll
                    for (int mm = m; mm < m + 2; ++mm)
#pragma unroll
                      for (int bj = 0; bj < 2; ++bj) { const size_t ro2 = (size_t)(row0 + ai * HALF + mm * 16) * ldc + col0 + bj * HALF; hq[mm][bj] = *(const u32x4*)(Hin + ro2); pq[mm][bj] = *(const u32x4*)(PP + ro2); } }
                  const size_t ro = (size_t)(row0 + ai * HALF + m * 16) * ldc + col0; const float rsi = rstd_of(ssq_to_f(q_[ai][m])); float ss = 0.f;
#pragma unroll
                    for (int bj = 0; bj < 2; ++bj) { const u32x4 hw = hq[m][bj], pw = pq[m][bj];
                        const float h[8] = {bf_lo(hw.x), bf_hi(hw.x), bf_lo(hw.y), bf_hi(hw.y), bf_lo(hw.z), bf_hi(hw.z), bf_lo(hw.w), bf_hi(hw.w)};
                        const float p[8] = {bf_lo(pw.x), bf_hi(pw.x), bf_lo(pw.y), bf_hi(pw.y), bf_lo(pw.z), bf_hi(pw.z), bf_lo(pw.w), bf_hi(pw.w)};
                        float v[8];
#pragma unroll
                        for (int j = 0; j < 4; ++j) { v[j] = h[j] + sigm(acc[ai][bj][m][0][j] * rsi) * p[j]; v[4 + j] = h[4 + j] + sigm(acc[ai][bj][m][1][j] * rsi) * p[4 + j]; }
                        u32x4 w; w.x = cvt_pk_bf16(v[0], v[1]); w.y = cvt_pk_bf16(v[2], v[3]); w.z = cvt_pk_bf16(v[4], v[5]); w.w = cvt_pk_bf16(v[6], v[7]);
                        *(u32x4*)(Hout + ro + bj * HALF) = w;
#pragma unroll
                        for (int j = 0; j < 8; ++j) ss += v[j] * v[j]; }
                    { const int ln_ = fq * 16 + fr; ss += __builtin_bit_cast(float, __builtin_amdgcn_ds_bpermute((ln_ ^ 16) << 2, __builtin_bit_cast(int, ss))); ss += __builtin_bit_cast(float, __builtin_amdgcn_ds_bpermute((ln_ ^ 32) << 2, __builtin_bit_cast(int, ss))); }
                    if (fq == 0) ss_add(SSo + row0 + ai * HALF + m * 16, ss);
                    if (m & 1) asm volatile("" ::: "memory"); } }
        } else { bf16_t* base = SLAB + ((size_t)u.ks * (2 * BM) + (size_t)(u.pm - PMT) * BM + wr * 64 + fr) * ldc + col0;
#pragma unroll
            for (int ai = 0; ai < 2; ++ai)
#pragma unroll
                for (int m = 0; m < 4; ++m) { bf16_t* rowp = base + (size_t)(ai * HALF + m * 16) * ldc;
#pragma unroll
                    for (int bj = 0; bj < 2; ++bj) { const f32x4 a0 = acc[ai][bj][m][0], a1 = acc[ai][bj][m][1]; u32x4 w; w.x = cvt_pk_bf16(a0[0], a0[1]); w.y = cvt_pk_bf16(a0[2], a0[3]); w.z = cvt_pk_bf16(a1[0], a1[1]); w.w = cvt_pk_bf16(a1[2], a1[3]); *(u32x4*)(rowp + bj * HALF) = w; } }
        }
    }
};

struct EpiSlabBf16 {
    static constexpr bool PERM = true, AFTER_DRAIN = false;
    bf16_t* SLAB; int ldc, mrows;
    __device__ __forceinline__ void operator()(const f32x4 (&acc)[2][2][4][2], const Unit& u, int wr, int wc, int fr, int fq) const {
        bf16_t* base = SLAB + ((size_t)u.ks * mrows + (size_t)u.pm * BM + wr * 64 + fr) * ldc + u.pn * BM + wc * 32 + 8 * fq;
#pragma unroll
        for (int ai = 0; ai < 2; ++ai)
#pragma unroll
            for (int m = 0; m < 4; ++m) { bf16_t* rowp = base + (size_t)(ai * HALF + m * 16) * ldc;
#pragma unroll
                for (int bj = 0; bj < 2; ++bj) { const f32x4 a0 = acc[ai][bj][m][0], a1 = acc[ai][bj][m][1]; u32x4 w; w.x = cvt_pk_bf16(a0[0], a0[1]); w.y = cvt_pk_bf16(a0[2], a0[3]); w.z = cvt_pk_bf16(a1[0], a1[1]); w.w = cvt_pk_bf16(a1[2], a1[3]); *(u32x4*)(rowp + bj * HALF) = w; } }
    }
};

template <class Epi, class Sched, bool ALIGN_EPI = false, bool SP2 = false>
__device__ __forceinline__ void gemm_phase(PG8_LAS unsigned char* lds, const Gemm g, const Sched& S, const Epi& E) {
    int tid_ = threadIdx.x; asm volatile("" : "+v"(tid_));
    const int tid = tid_, wid = __builtin_amdgcn_readfirstlane(tid >> 6), lane = tid & 63, wr = wid >> 2, wc = wid & 3, fr = lane & 15, fq = lane >> 4;
    const int lda = g.lda ? g.lda : g.K, ldb = g.ldb ? g.ldb : g.K;
    unsigned voffA[2], voffB[2];
#pragma unroll
    for (int i = 0; i < 2; ++i) { int R, C; stage_rc(tid * 16 + i * 8192, R, C); const int Rb = Epi::PERM ? ((R & ~31) + perm32(R & 31)) : R;
        voffA[i] = (unsigned)(R * lda + C) * 2u; voffB[i] = (unsigned)(Rb * ldb + C) * 2u; }
    const size_t kstep = (size_t)(BK * 2);
    const size_t hstepA = (size_t)HALF * lda * 2, hstepB = (size_t)HALF * ldb * 2;
    const size_t tstepA = 2 * hstepA, tstepB = 2 * hstepB;
    const unsigned ldsw = (unsigned)wid * 1024u;
    const int aoff = lds_byte(wr * 64 + fr, fq * 8), boff = lds_byte(wc * 32 + fr, fq * 8);
#define PG8_SA(b, h) (((b) * 2 + (h)) * HTB)
#define PG8_SB(b, h) ((4 + (b) * 2 + (h)) * HTB)
#define PG8_STAGE(bufoff, gbase, voff) do { _Pragma("unroll") for (int _i = 0; _i < 2; ++_i) \
        __builtin_amdgcn_global_load_lds((const unsigned*)((const char*)(gbase) + (voff)[_i]), (PG8_LAS unsigned*)(lds + (bufoff) + ldsw + _i * 8192), 16, 0, 0); } while (0)
#define PG8_LDA(dst, b, h) do { _Pragma("unroll") for (int m = 0; m < 4; ++m) _Pragma("unroll") for (int k = 0; k < 2; ++k) dst[m][k] = *(const PG8_LAS bf16x8*)(lds + PG8_SA(b, h) + aoff + m * 2048 + k * 1024); } while (0)
#define PG8_LDB(dst, b, h) do { _Pragma("unroll") for (int n = 0; n < 2; ++n) _Pragma("unroll") for (int k = 0; k < 2; ++k) dst[n][k] = *(const PG8_LAS bf16x8*)(lds + PG8_SB(b, h) + boff + n * 2048 + k * 1024); } while (0)
#define PG8_MMA(ai, bj, At, Bt) do { __builtin_amdgcn_s_setprio(1); _Pragma("unroll") for (int m = 0; m < 4; ++m) _Pragma("unroll") for (int n = 0; n < 2; ++n) _Pragma("unroll") for (int k = 0; k < 2; ++k) \
        acc[ai][bj][m][n] = __builtin_amdgcn_mfma_f32_16x16x32_bf16(Bt[n][k], At[m][k], acc[ai][bj][m][n], 0, 0, 0); __builtin_amdgcn_s_setprio(0); } while (0)
#define PG8_WAIT_V(n) asm volatile("s_waitcnt vmcnt(" #n ")" ::: "memory")
#define PG8_WAIT_L(n) asm volatile("s_waitcnt lgkmcnt(" #n ")" ::: "memory")
#define PG8_BAR __builtin_amdgcn_s_barrier()
#define PG8_SCHED __builtin_amdgcn_sched_barrier(0)
    Unit cur, nxt; int ui = 0;
    if (!S.next(0, cur)) return;
    f32x4 acc[2][2][4][2];
#pragma unroll
    for (int a = 0; a < 2; ++a)
#pragma unroll
        for (int b = 0; b < 2; ++b)
#pragma unroll
            for (int m = 0; m < 4; ++m)
#pragma unroll
                for (int n = 0; n < 2; ++n) acc[a][b][m][n] = (f32x4){0.f, 0.f, 0.f, 0.f};
    bf16x8 At[4][2], B0[2][2], B1[2][2];
    const char* cA = (const char*)g.A + (size_t)cur.br * g.abr + (size_t)cur.pm * tstepA + (size_t)cur.k0 * 2; const char* cB = (const char*)g.Bt + (size_t)cur.br * g.bbr + (size_t)cur.pn * tstepB + (size_t)cur.k0 * 2;
    S.a_ready(cur);
    if constexpr (SP2) {
        PG8_STAGE(PG8_SB(0, 0), cB, voffB); PG8_STAGE(PG8_SB(0, 1), cB + hstepB, voffB); PG8_STAGE(PG8_SA(0, 0), cA, voffA); PG8_STAGE(PG8_SA(0, 1), cA + hstepA, voffA);
        if (wr == 1) PG8_BAR;
        PG8_WAIT_V(2); PG8_BAR;
        PG8_STAGE(PG8_SB(1, 0), cB + kstep, voffB); PG8_STAGE(PG8_SA(1, 0), cA + kstep, voffA); PG8_STAGE(PG8_SB(1, 1), cB + hstepB + kstep, voffB);
        PG8_WAIT_V(6); PG8_BAR;
    } else {
        PG8_STAGE(PG8_SB(0, 0), cB, voffB); PG8_STAGE(PG8_SA(0, 0), cA, voffA); PG8_STAGE(PG8_SB(0, 1), cB + hstepB, voffB); PG8_STAGE(PG8_SA(0, 1), cA + hstepA, voffA);
        if (wr == 1) PG8_BAR;
        PG8_WAIT_V(4); PG8_BAR;
        PG8_STAGE(PG8_SB(1, 0), cB + kstep, voffB); PG8_STAGE(PG8_SA(1, 0), cA + kstep, voffA); PG8_STAGE(PG8_SB(1, 1), cB + hstepB + kstep, voffB);
        PG8_WAIT_V(6); PG8_BAR;
    }
    for (;;) {
        const bool has_next = S.next(ui + 1, nxt);
        const char* nA = has_next ? (const char*)g.A + (size_t)nxt.br * g.abr + (size_t)nxt.pm * tstepA + (size_t)nxt.k0 * 2 : cA; const char* nB = has_next ? (const char*)g.Bt + (size_t)nxt.br * g.bbr + (size_t)nxt.pn * tstepB + (size_t)nxt.k0 * 2 : cB;
        const int nt = cur.nt;
        for (int t = 0; t < nt; t += 2) {
            const bool last = (t == nt - 2);
            const char* a1 = cA + (size_t)(t + 1) * kstep;
            const char* a2 = last ? nA : cA + (size_t)(t + 2) * kstep; const char* b2 = last ? nB : cB + (size_t)(t + 2) * kstep;
            const char* a3 = a2 + kstep; const char* b3 = b2 + kstep;
            if (last && has_next) S.a_ready(nxt);
            if constexpr (SP2) {
            PG8_LDB(B0, 0, 0); PG8_LDB(B1, 0, 1); PG8_SCHED; PG8_LDA(At, 0, 0); PG8_STAGE(PG8_SA(1, 1), a1 + hstepA, voffA);
            PG8_WAIT_V(8); PG8_WAIT_L(0); PG8_BAR; PG8_MMA(0, 0, At, B0); PG8_MMA(0, 1, At, B1); PG8_BAR; PG8_SCHED;
            PG8_LDA(At, 0, 1); PG8_STAGE(PG8_SB(0, 0), b2, voffB); PG8_STAGE(PG8_SB(0, 1), b2 + hstepB, voffB); PG8_STAGE(PG8_SA(0, 0), a2, voffA);
            PG8_WAIT_V(8); PG8_WAIT_L(0); PG8_BAR; PG8_MMA(1, 0, At, B0); PG8_MMA(1, 1, At, B1); PG8_BAR; PG8_SCHED;
            PG8_LDB(B0, 1, 0); PG8_LDB(B1, 1, 1); PG8_SCHED; PG8_LDA(At, 1, 0); PG8_STAGE(PG8_SA(0, 1), a2 + hstepA, voffA);
            PG8_WAIT_V(8); PG8_WAIT_L(0); PG8_BAR; PG8_MMA(0, 0, At, B0); PG8_MMA(0, 1, At, B1); PG8_BAR; PG8_SCHED;
            PG8_LDA(At, 1, 1); PG8_STAGE(PG8_SB(1, 0), b3, voffB); PG8_STAGE(PG8_SB(1, 1), b3 + hstepB, voffB); PG8_STAGE(PG8_SA(1, 0), a3, voffA);
            PG8_WAIT_V(8); PG8_WAIT_L(0); PG8_BAR; PG8_MMA(1, 0, At, B0); PG8_MMA(1, 1, At, B1); PG8_BAR; PG8_SCHED;
            } else {
            PG8_LDB(B0, 0, 0); PG8_SCHED; PG8_LDA(At, 0, 0); PG8_STAGE(PG8_SA(1, 1), a1 + hstepA, voffA);
            PG8_WAIT_L(8); PG8_BAR; PG8_WAIT_L(0); PG8_MMA(0, 0, At, B0); PG8_BAR; PG8_SCHED;
            PG8_LDB(B1, 0, 1); PG8_STAGE(PG8_SB(0, 0), b2, voffB);
            PG8_BAR; PG8_WAIT_L(0); PG8_MMA(0, 1, At, B1); PG8_BAR;
            PG8_LDA(At, 0, 1); PG8_STAGE(PG8_SA(0, 0), a2, voffA);
            PG8_BAR; PG8_WAIT_L(0); PG8_MMA(1, 0, At, B0); PG8_BAR; PG8_SCHED;
            PG8_STAGE(PG8_SB(0, 1), b2 + hstepB, voffB);
            PG8_WAIT_V(6); PG8_BAR; PG8_MMA(1, 1, At, B1); PG8_BAR;
            PG8_LDB(B0, 1, 0); PG8_SCHED; PG8_LDA(At, 1, 0); PG8_STAGE(PG8_SA(0, 1), a2 + hstepA, voffA);
            PG8_WAIT_L(8); PG8_BAR; PG8_WAIT_L(0); PG8_MMA(0, 0, At, B0); PG8_BAR; PG8_SCHED;
            PG8_LDB(B1, 1, 1); PG8_STAGE(PG8_SB(1, 0), b3, voffB);
            PG8_BAR; PG8_WAIT_L(0); PG8_MMA(0, 1, At, B1); PG8_BAR;
            PG8_LDA(At, 1, 1); PG8_STAGE(PG8_SA(1, 0), a3, voffA);
            PG8_BAR; PG8_WAIT_L(0); PG8_MMA(1, 0, At, B0); PG8_BAR; PG8_SCHED;
            PG8_STAGE(PG8_SB(1, 1), b3 + hstepB, voffB);
            PG8_WAIT_V(6); PG8_BAR; PG8_MMA(1, 1, At, B1); PG8_BAR;
            }
        }
        if constexpr (ALIGN_EPI) { if (wr == 0) PG8_BAR; }
        if constexpr (!Epi::AFTER_DRAIN) { E(acc, cur, wr, wc, fr, fq);
#if defined(PROBE_EPI2)
            if constexpr (Epi::PERM) { if (cur.cont == 0 && cur.br == 0) E(acc, cur, wr, wc, fr, fq); }
#endif
            S.done(cur); }
        if (!has_next) break;
        if (!cur.cont) {
#pragma unroll
        for (int a = 0; a < 2; ++a)
#pragma unroll
            for (int b = 0; b < 2; ++b)
#pragma unroll
                for (int m = 0; m < 4; ++m)
#pragma unroll
                    for (int n = 0; n < 2; ++n) acc[a][b][m][n] = (f32x4){0.f, 0.f, 0.f, 0.f};
        }
        cur = nxt; cA = nA; cB = nB; ++ui;
        if constexpr (ALIGN_EPI) { if (wr == 1) PG8_BAR; }
    }
    PG8_WAIT_V(0);
    if constexpr (!ALIGN_EPI) { if (wr == 0) PG8_BAR; }
    PG8_BAR;
    if constexpr (Epi::AFTER_DRAIN) { E.fused(acc, cur, wr, wc, fr, fq, lds, wid, lane); S.done(cur); }
#undef PG8_SA
#undef PG8_SB
#undef PG8_STAGE
#undef PG8_LDA
#undef PG8_LDB
#undef PG8_MMA
#undef PG8_WAIT_V
#undef PG8_WAIT_L
#undef PG8_BAR
#undef PG8_SCHED
}
}
#ifndef PG8_SP2
#define PG8_SP2 true
#endif
#ifndef PG8_ALIGN
#define PG8_ALIGN true
#endif
#ifndef MK_PER_PHASE
#define MK_PER_PHASE 0
#endif

constexpr int NWAVES = 8;
constexpr int DM = 2048, DEPTH = 4, MP = 8192, MS = 512, MTOK = MP + MS;
constexpr int SEQ = 4096, DSEQ = 32, DBATCH = 16, PBATCH = 2;
constexpr int CONVD = 1024, CONVW = 31, GMD = 1024, NHEAD = 8, HDIM = 128, ATD = 1024, DFF = 8192, PLED = 256;
constexpr int INC = 13312, ZG = 7168;
constexpr int ZA = 0, ZB = 1024, ZQ = 3072, ZK = 4096, ZV = 5120;
constexpr int ZP = 6144;
constexpr int WCACHE = 512;
constexpr float EPS = 1e-6f;
constexpr size_t O_YP = 0, O_YS = 16777216, O_CSP = 17825792, O_CSS = 18071552, O_KP = 20037632, O_VP = 24231936, O_KS = 28426240, O_VS = 30523392, O_GV = 32620544, O_END = 34717696;
constexpr size_t MiB = 1u << 20;
constexpr size_t WS_CTL = 0, CTL_ZERO_BYTES = 1 * MiB;
constexpr int LD_T = DFF + 64;
constexpr int LD2 = DM, LD1 = CONVD;
constexpr size_t WS_WT = 1 * MiB, WT_LAYER = 154 * MiB;
constexpr size_t WT_IN = 0, WT_A = 54 * MiB, WT_B = 59 * MiB, WT_C = 64 * MiB, WT_O = 69 * MiB, WT_F1 = 78 * MiB, WT_F2 = 111 * MiB, WT_PG = 144 * MiB, WT_PP = 153 * MiB;
constexpr size_t WS_H = 617 * MiB, WS_XN = 685 * MiB, WS_Z = 721 * MiB, WS_YA = 942 * MiB, WS_YB = 961 * MiB, WS_O = 980 * MiB, WS_V = 999 * MiB, WS_MG = 1016 * MiB, WS_MERGED = 1084 * MiB, WS_PLE = 1120 * MiB, WS_SLAB = 1137 * MiB, WS_SS = 1201 * MiB, WS_PP4 = 1202 * MiB, WS_G8 = 1338 * MiB, WS_END = 1390 * MiB;
constexpr size_t WS_T = WS_Z;
static_assert(WS_WT + 4 * WT_LAYER == WS_H && WS_Z + (size_t)MTOK * ZP * 2 <= WS_YA && WS_T + (size_t)MTOK * LD_T * 2 <= WS_YA && WT_F2 + (size_t)DM * LD_T * 2 <= WT_PG && WT_IN + (size_t)INC * LD2 * 2 <= WT_A && WT_F1 + (size_t)DFF * LD2 * 2 <= WT_F2 && WT_O + (size_t)DM * LD2 * 2 <= WT_F1 && WT_PG + (size_t)DM * LD2 * 2 <= WT_PP && WS_XN + (size_t)MTOK * LD2 * 2 <= WS_Z && WS_MERGED + (size_t)MTOK * LD2 * 2 <= WS_PLE && WS_YA + (size_t)MTOK * LD1 * 2 <= WS_YB && WS_O + (size_t)MTOK * LD1 * 2 <= WS_V, "ws map");
constexpr int CW_BAR = 4096;

constexpr int RING_OFF = 0, RING_BYTES = 131072;
constexpr int LDSCTL_OFF = RING_BYTES, MISC_OFF = LDSCTL_OFF + 320;
constexpr int LDS_BYTES = 147456;

#define GAS __attribute__((address_space(1)))
#define LAS __attribute__((address_space(3)))
typedef unsigned short bf16;
typedef unsigned v4u __attribute__((ext_vector_type(4)));
typedef float f32x4 __attribute__((ext_vector_type(4)));
typedef short bf16x8 __attribute__((ext_vector_type(8)));
typedef GAS unsigned gu32;
typedef GAS unsigned long long gu64;
#define RLX_AGENT __ATOMIC_RELAXED, __HIP_MEMORY_SCOPE_AGENT
#define LDS_WAIT() asm volatile("s_waitcnt lgkmcnt(0)" ::: "memory")
#define VM_WAIT() asm volatile("s_waitcnt vmcnt(0)" ::: "memory")
__device__ __forceinline__ unsigned long long rt() { return __builtin_amdgcn_s_memrealtime(); }
__device__ __forceinline__ unsigned f2bf(float f) { unsigned u = __builtin_bit_cast(unsigned, f); return (u + 0x7fffu + ((u >> 16) & 1u)) >> 16; }
__device__ __forceinline__ unsigned pk2(float lo, float hi) { return f2bf(lo) | (f2bf(hi) << 16); }

#define XB_TMO      128
#define XB_XCNT(j)  (256  + 64 * (j))
#define XB_XSUB(j)  (1280 + 64 * (j))
#define XB_XGEN(j)  (2304 + 64 * (j))
#define XB_TOP      3328
#define XB_TOPGEN   3392
#define XCD_BAR_WORDS 3456
#define XB_SPIN_CAP (1u << 18)

__device__ __forceinline__ unsigned xb_ld(unsigned* p)              { return __hip_atomic_load(p, __ATOMIC_RELAXED, __HIP_MEMORY_SCOPE_AGENT); }
__device__ __forceinline__ unsigned xb_add(unsigned* p, unsigned v) { return __hip_atomic_fetch_add(p, v, __ATOMIC_RELAXED, __HIP_MEMORY_SCOPE_AGENT); }
__device__ __forceinline__ unsigned xb_xcc_id() { return (unsigned)__builtin_amdgcn_s_getreg((3 << 11) | 20) & 0xFu; }
#define XB_SPIN(cond, bar) do { unsigned _sp = 0; while (cond) { __builtin_amdgcn_s_sleep(1); \
    if ((++_sp & 255u) == 0u) { if (xb_ld(&(bar)[XB_TMO])) break; if (_sp > XB_SPIN_CAP) { atomicAdd(&(bar)[XB_TMO], 1u); break; } } } } while (0)

struct XcdBarrier {
    unsigned* bar; unsigned x;
    volatile LAS unsigned* st;
};

__device__ __forceinline__ XcdBarrier xcd_barrier_post(unsigned* bar, volatile LAS unsigned* st) {
    XcdBarrier b; b.bar = bar; b.x = xb_xcc_id(); b.st = st;
    if (threadIdx.x == 0) (void)xb_add(&bar[XB_XCNT(b.x)], 1u);
    return b;
}
__device__ __forceinline__ void xcd_barrier_complete(unsigned* bar, unsigned x, unsigned& nloc, unsigned& nx) {
    const unsigned G = gridDim.x * gridDim.y * gridDim.z;
    unsigned sum, cnt, mine, sp = 0u;
    for (;;) {
        sum = 0u; cnt = 0u; mine = 0u;
#pragma unroll
        for (unsigned j = 0; j < 16; ++j) { const unsigned c = xb_ld(&bar[XB_XCNT(j)]); sum += c; cnt += (c > 0u) ? 1u : 0u; mine = (j == x) ? c : mine; }
        if (sum == G) break;
        __builtin_amdgcn_s_sleep(1);
        if ((++sp & 255u) == 0u) { if (xb_ld(&bar[XB_TMO])) break; if (sp > XB_SPIN_CAP) { atomicAdd(&bar[XB_TMO], 1u); break; } }
    }
    nloc = mine > 0u ? mine : 1u; nx = cnt > 0u ? cnt : 1u;
}

__device__ __forceinline__ void xcd_barrier(const XcdBarrier& b) {
    asm volatile("s_waitcnt vmcnt(0)" ::: "memory");
    __syncthreads();
    if (threadIdx.x == 0) {
        unsigned* bar = b.bar;
        __builtin_amdgcn_s_waitcnt(0);
        unsigned nloc = b.st[0], nx = b.st[1];
        if (nloc == 0u) { xcd_barrier_complete(bar, b.x, nloc, nx); b.st[0] = nloc; b.st[1] = nx; }
        const unsigned old = xb_add(&bar[XB_XSUB(b.x)], 1u);
        const unsigned gen = old / nloc;
        if (old + 1u == (gen + 1u) * nloc) {
            __builtin_amdgcn_fence(__ATOMIC_RELEASE, "agent");
            asm volatile("s_waitcnt vmcnt(0)" ::: "memory");
            const unsigned og = xb_add(&bar[XB_TOP], 1u);
            const unsigned tg = og / nx;
            if (og + 1u == (tg + 1u) * nx) xb_add(&bar[XB_TOPGEN], 1u);
            else XB_SPIN(xb_ld(&bar[XB_TOPGEN]) == tg, bar);
            __builtin_amdgcn_fence(__ATOMIC_ACQUIRE, "agent");
            xb_add(&bar[XB_XGEN(b.x)], 1u);
            asm volatile("s_waitcnt vmcnt(0)" ::: "memory");
        } else {
            XB_SPIN(xb_ld(&bar[XB_XGEN(b.x)]) == gen, bar);
            __builtin_amdgcn_fence(__ATOMIC_ACQUIRE, "agent");
            asm volatile("s_waitcnt vmcnt(0)" ::: "memory");
        }
    }
    __syncthreads();
}
typedef unsigned u32x2g __attribute__((ext_vector_type(2)));
typedef float f32x2g __attribute__((ext_vector_type(2)));
__device__ __forceinline__ float shx(float v, int o, int lane) { return __builtin_bit_cast(float, __builtin_amdgcn_ds_bpermute((lane ^ o) << 2, __builtin_bit_cast(int, v))); }
__device__ __forceinline__ float wave_sum(float v, int lane) {
    (void)lane;
#define WS_DPP(CTRL) v += __builtin_bit_cast(float, __builtin_amdgcn_update_dpp(0, __builtin_bit_cast(int, v), CTRL, 0xF, 0xF, true))
    WS_DPP(0xB1); WS_DPP(0x4E); WS_DPP(0x141); WS_DPP(0x140);
#undef WS_DPP
    const int x = __builtin_bit_cast(int, v);
    const float s0 = __builtin_bit_cast(float, __builtin_amdgcn_readlane(x, 0)), s1 = __builtin_bit_cast(float, __builtin_amdgcn_readlane(x, 16));
    const float s2 = __builtin_bit_cast(float, __builtin_amdgcn_readlane(x, 32)), s3 = __builtin_bit_cast(float, __builtin_amdgcn_readlane(x, 48));
    return (s0 + s1) + (s2 + s3);
}
__device__ __forceinline__ void unpack8(const v4u w, float (&f)[8]) { f[0] = pg8::bf_lo(w.x); f[1] = pg8::bf_hi(w.x); f[2] = pg8::bf_lo(w.y); f[3] = pg8::bf_hi(w.y); f[4] = pg8::bf_lo(w.z); f[5] = pg8::bf_hi(w.z); f[6] = pg8::bf_lo(w.w); f[7] = pg8::bf_hi(w.w); }
__device__ __forceinline__ v4u pack8(const float (&f)[8]) { v4u o; o.x = pk2(f[0], f[1]); o.y = pk2(f[2], f[3]); o.z = pk2(f[4], f[5]); o.w = pk2(f[6], f[7]); return o; }
__device__ __forceinline__ float gelu_tanh(float x) { return x * pg8::sigm(1.5957691216057308f * (x + 0.044715f * x * x * x)); }
__device__ __forceinline__ void load8f(const float* p, float (&f)[8]) { const f32x4 a = *(const f32x4*)p, b = *(const f32x4*)(p + 4); f[0] = a[0]; f[1] = a[1]; f[2] = a[2]; f[3] = a[3]; f[4] = b[0]; f[5] = b[1]; f[6] = b[2]; f[7] = b[3]; }
__device__ __forceinline__ void store8f(float* p, const float (&f)[8]) { *(f32x4*)p = (f32x4){f[0], f[1], f[2], f[3]}; *(f32x4*)(p + 4) = (f32x4){f[4], f[5], f[6], f[7]}; }

struct P0Item { const float* W; bf16* WT; const float* gain; int K, N, r, ldw, glu; };
__device__ __forceinline__ void p0_item_load(const P0Item& d, float (&v)[32], float (&g)[8], int lane) {
    const int nblk = d.N / 32, kb = d.r / nblk, nb = d.r % nblk; const float* src = d.W + (size_t)(64 * kb + (lane >> 5)) * d.N + 32 * nb + (lane & 31);
#pragma unroll
    for (int i = 0; i < 32; ++i) v[i] = src[(size_t)(2 * i) * d.N];
    if (d.gain) load8f(d.gain + 64 * kb + 8 * (lane & 7), g); else {
#pragma unroll
        for (int i = 0; i < 8; ++i) g[i] = 1.0f; }
}
__device__ __forceinline__ void p0_item_store(const P0Item& d, const float (&v)[32], LAS float* scr, int lane) {
#pragma unroll
    for (int i = 0; i < 32; ++i) scr[(2 * i + (lane >> 5)) * 33 + (lane & 31)] = v[i];
}
__device__ __forceinline__ void p0_item_flush(const P0Item& d, const float (&g)[8], LAS float* scr, int lane) {
    const int nblk = d.N / 32, kb = d.r / nblk, nb = d.r % nblk, k0 = 64 * kb, n0 = 32 * nb;
    LDS_WAIT(); asm volatile("" ::: "memory");
    const int c = lane & 7;
#pragma unroll
    for (int j = 0; j < 4; ++j) { const int n = (lane >> 3) + 8 * j; const LAS float* s = scr + (8 * c) * 33 + n;
        v4u o; o.x = pk2(s[0 * 33] * g[0], s[1 * 33] * g[1]); o.y = pk2(s[2 * 33] * g[2], s[3 * 33] * g[3]); o.z = pk2(s[4 * 33] * g[4], s[5 * 33] * g[5]); o.w = pk2(s[6 * 33] * g[6], s[7 * 33] * g[7]);
        int nr = n0 + n; if (nr < 2 * d.glu) { const int cch = nr < d.glu ? nr : nr - d.glu; nr = 8 * (cch >> 2) + (cch & 3) + (nr < d.glu ? 0 : 4); }
        *(GAS v4u*)(d.WT + (size_t)nr * d.ldw + k0 + 8 * c) = o; }
    LDS_WAIT(); asm volatile("" ::: "memory");
}

__device__ __forceinline__ void p0w_load(const P0Item& d, f32x4 (&v)[8], float (&g)[8], int wave, int lane) {
    const int nblk = d.N / 256, kb = d.r / nblk, nb = d.r % nblk; const float* src = d.W + (size_t)(64 * kb + wave) * d.N + 256 * nb + 4 * lane;
#pragma unroll
    for (int p = 0; p < 8; ++p) v[p] = *(const f32x4*)(src + (size_t)(8 * p) * d.N);
    load8f(d.gain ? d.gain + 64 * kb + 8 * (lane & 7) : d.W, g);
}
__device__ __forceinline__ void p0w_store(const f32x4 (&v)[8], LAS float* T, int wave, int lane) {
#pragma unroll
    for (int p = 0; p < 8; ++p) { LAS float* t = T + (8 * p + wave) * 257 + 4 * lane; t[0] = v[p][0]; t[1] = v[p][1]; t[2] = v[p][2]; t[3] = v[p][3]; }
}
__device__ __forceinline__ void p0w_flush(const P0Item& d, const float (&g_)[8], const LAS float* T, int wave, int lane) {
    const int nblk = d.N / 256, kb = d.r / nblk, nb = d.r % nblk, k0 = 64 * kb, n0 = 256 * nb + 32 * wave;
    const int c = lane & 7; float g[8];
#pragma unroll
    for (int i = 0; i < 8; ++i) g[i] = d.gain ? g_[i] : 1.0f;
#pragma unroll
    for (int j = 0; j < 4; ++j) { const int n = (lane >> 3) + 8 * j; const LAS float* s = T + (8 * c) * 257 + 32 * wave + n;
        v4u o; o.x = pk2(s[0 * 257] * g[0], s[1 * 257] * g[1]); o.y = pk2(s[2 * 257] * g[2], s[3 * 257] * g[3]); o.z = pk2(s[4 * 257] * g[4], s[5 * 257] * g[5]); o.w = pk2(s[6 * 257] * g[6], s[7 * 257] * g[7]);
        int nr = n0 + n; if (nr < 2 * d.glu) { const int cch = nr < d.glu ? nr : nr - d.glu; nr = 8 * (cch >> 2) + (cch & 3) + (nr < d.glu ? 0 : 4); }
        *(GAS v4u*)(d.WT + (size_t)nr * d.ldw + k0 + 8 * c) = o; }
}

template <int S, int MODE> __device__ __forceinline__ void load_row_folded(int row, float* H, const float* SLAB, const bf16* PP, f32x4 (&v)[8], int lane) {
    constexpr int mode = MODE;
    f32x4* hr = (f32x4*)(H + (size_t)row * DM) + lane;
#pragma unroll
    for (int j = 0; j < 8; ++j) v[j] = hr[64 * j];
    if (mode != 0 && row >= MP) {
        const f32x4* sl = (const f32x4*)(SLAB + (size_t)(row - MP) * DM) + lane;
#pragma unroll
        for (int j = 0; j < 8; ++j) { f32x4 a = (f32x4){0.f, 0.f, 0.f, 0.f};
            f32x4 t_[S];
#pragma unroll
            for (int s = 0; s < S; ++s) t_[s] = sl[(size_t)s * (MS * DM / 4) + 64 * j];
#pragma unroll
            for (int s = 0; s < S; ++s) a += t_[s];
            if (mode == 1) v[j] += a;
            else { const u32x2g pw = ((const u32x2g*)(PP + (size_t)row * DM))[lane + 64 * j];
                v[j][0] += pg8::sigm(a[0]) * pg8::bf_lo(pw.x); v[j][1] += pg8::sigm(a[1]) * pg8::bf_hi(pw.x); v[j][2] += pg8::sigm(a[2]) * pg8::bf_lo(pw.y); v[j][3] += pg8::sigm(a[3]) * pg8::bf_hi(pw.y); }
            hr[64 * j] = v[j]; }
    }
}
template <int S, int MODE> __device__ __forceinline__ void rms_row_bf16(int row, float* H, const float* SLAB, const bf16* PP, const float* gain, bf16* orow, int lane) {
    const f32x4* gr = (const f32x4*)gain + lane;
    f32x4 v[8]; float s = 0.f; load_row_folded<S, MODE>(row, H, SLAB, PP, v, lane);
#pragma unroll
    for (int j = 0; j < 8; ++j) s += (v[j][0] * v[j][0] + v[j][1] * v[j][1]) + (v[j][2] * v[j][2] + v[j][3] * v[j][3]);
    const float rstd = 1.0f / sqrtf(wave_sum(s, lane) * (1.f / DM) + EPS);
    u32x2g* o8 = (u32x2g*)orow + lane;
#pragma unroll
    for (int j = 0; j < 8; ++j) { const f32x4 g = gr[64 * j]; u32x2g w; w.x = pk2(v[j][0] * rstd * g[0], v[j][1] * rstd * g[1]); w.y = pk2(v[j][2] * rstd * g[2], v[j][3] * rstd * g[3]); o8[64 * j] = w; }
}
template <int S, int MODE> __device__ __forceinline__ void rms_row_f32(int row, float* H, const float* SLAB, const bf16* PP, const float* gain, float* orow, int lane) {
    const f32x4* gr = (const f32x4*)gain + lane;
    f32x4 v[8]; float s = 0.f; load_row_folded<S, MODE>(row, H, SLAB, PP, v, lane);
#pragma unroll
    for (int j = 0; j < 8; ++j) s += (v[j][0] * v[j][0] + v[j][1] * v[j][1]) + (v[j][2] * v[j][2] + v[j][3] * v[j][3]);
    const float rstd = 1.0f / sqrtf(wave_sum(s, lane) * (1.f / DM) + EPS);
    f32x4* o = (f32x4*)orow + lane;
#pragma unroll
    for (int j = 0; j < 8; ++j) { const f32x4 g = gr[64 * j]; o[64 * j] = v[j] * rstd * g; }
}

__device__ __forceinline__ void rms_row_bf16_to_f32(const bf16* hrow, const float* gain, float* orow, int lane) {
    const u32x2g* hr = (const u32x2g*)hrow + lane; const f32x4* gr = (const f32x4*)gain + lane;
    f32x4 v[8], g[8]; float s = 0.f;
#pragma unroll
    for (int j = 0; j < 8; ++j) g[j] = gr[64 * j];
#pragma unroll
    for (int j = 0; j < 8; ++j) { const u32x2g w = hr[64 * j]; v[j] = (f32x4){pg8::bf_lo(w.x), pg8::bf_hi(w.x), pg8::bf_lo(w.y), pg8::bf_hi(w.y)}; s += (v[j][0] * v[j][0] + v[j][1] * v[j][1]) + (v[j][2] * v[j][2] + v[j][3] * v[j][3]); }
    const float rstd = 1.0f / sqrtf(wave_sum(s, lane) * (1.f / DM) + EPS);
    f32x4* o = (f32x4*)orow + lane;
#pragma unroll
    for (int j = 0; j < 8; ++j) o[64 * j] = v[j] * rstd * g[j];
}
__device__ __forceinline__ void rms_rows_bf16_to_f32(const bf16* H, const float* gain, float* O, int row0, int stride, int nrows, int lane) {
    if (row0 >= nrows) return;
    const f32x4* gr = (const f32x4*)gain + lane; f32x4 g[8]; u32x2g wr_[8], wn_[8];
#pragma unroll
    for (int j = 0; j < 8; ++j) { wr_[j] = ((const u32x2g*)(H + (size_t)row0 * DM) + lane)[64 * j]; g[j] = gr[64 * j]; }
    for (int row = row0; row < nrows; row += stride) {
        const bool more = row + stride < nrows; const int nx = more ? row + stride : row;
#pragma unroll
        for (int j = 0; j < 8; ++j) wn_[j] = ((const u32x2g*)(H + (size_t)nx * DM) + lane)[64 * j];
        f32x4 v[8]; float s = 0.f;
#pragma unroll
        for (int j = 0; j < 8; ++j) { const u32x2g w = wr_[j]; v[j] = (f32x4){pg8::bf_lo(w.x), pg8::bf_hi(w.x), pg8::bf_lo(w.y), pg8::bf_hi(w.y)}; s += (v[j][0] * v[j][0] + v[j][1] * v[j][1]) + (v[j][2] * v[j][2] + v[j][3] * v[j][3]); }
        const float rstd = 1.0f / sqrtf(wave_sum(s, lane) * (1.f / DM) + EPS);
        f32x4* o = (f32x4*)(O + (size_t)row * DM) + lane;
#pragma unroll
        for (int j = 0; j < 8; ++j) o[64 * j] = v[j] * rstd * g[j];
#pragma unroll
        for (int j = 0; j < 8; ++j) wr_[j] = wn_[j];
    }
}
template <int S> __device__ __forceinline__ void sample_row_fix_t(int rs, const bf16* SLAB, const pg8::ssq_t* SSi, bf16* T, int wave, int lane) {
    const int c = (wave * 64 + lane) * 16; const float rsi = pg8::rstd_of(pg8::ss_load(SSi + MP + rs));
    float a[16];
#pragma unroll
    for (int i = 0; i < 16; ++i) a[i] = 0.f;
    v4u t_[S][2];
#pragma unroll
    for (int s = 0; s < S; ++s) { const v4u* sp = (const v4u*)(SLAB + ((size_t)s * MS + rs) * DFF + c); t_[s][0] = sp[0]; t_[s][1] = sp[1]; }
#pragma unroll
    for (int s = 0; s < S; ++s) { float f[8]; unpack8(t_[s][0], f);
#pragma unroll
        for (int i = 0; i < 8; ++i) a[i] += f[i];
        unpack8(t_[s][1], f);
#pragma unroll
        for (int i = 0; i < 8; ++i) a[8 + i] += f[i]; }
    unsigned long long* dst = (unsigned long long*)(T + (size_t)(MP + rs) * LD_T + c);
#pragma unroll
    for (int g = 0; g < 4; ++g) { float r[4];
#pragma unroll
        for (int i = 0; i < 4; ++i) { const float v = fmaxf(a[4 * g + i] * rsi, 0.f); r[i] = v * v; }
        __hip_atomic_store(dst + g, (unsigned long long)pk2(r[0], r[1]) | ((unsigned long long)pk2(r[2], r[3]) << 32), __ATOMIC_RELAXED, __HIP_MEMORY_SCOPE_AGENT); }
}
template <int S, int MODE, bool OUTF32> __device__ __forceinline__ void sample_rows_fix(int rs0, int dr, bool n2, int parity, const bf16* Hin, const bf16* SLAB, const bf16* PP, const pg8::ssq_t* SSi, bf16* HB, pg8::ssq_t* SSo, const float* gain, float* outf, LAS float* red, int wave, int lane) {
    const int q = wave * 64 + lane;
    f32x4 v[2]; f32x4 a[2]; u32x2g pw[2]; float rsi[2];
#pragma unroll
    for (int r = 0; r < 2; ++r) { v[r] = (f32x4){0.f, 0.f, 0.f, 0.f}; a[r] = v[r]; pw[r] = (u32x2g){0u, 0u}; rsi[r] = 0.f; }
    constexpr int SC = S < 8 ? S : 8;
#pragma unroll
    for (int r = 0; r < 2; ++r) if (r == 0 || n2) { const int rs = rs0 + r * dr, row = MP + rs;
        { const u32x2g hw = ((const u32x2g*)(Hin + (size_t)row * DM))[q]; v[r] = (f32x4){pg8::bf_lo(hw.x), pg8::bf_hi(hw.x), pg8::bf_lo(hw.y), pg8::bf_hi(hw.y)}; }
        if (MODE == 2) { pw[r] = ((const u32x2g*)(PP + (size_t)row * DM))[q]; rsi[r] = pg8::rstd_of(pg8::ss_load(SSi + row)); } }
    if (MODE != 0) {
#pragma unroll
        for (int s0 = 0; s0 < S; s0 += SC) { f32x4 t_[2][SC];
#pragma unroll
            for (int r = 0; r < 2; ++r) if (r == 0 || n2) { const u32x2g* sl = (const u32x2g*)(SLAB + (size_t)(rs0 + r * dr) * DM) + q;
#pragma unroll
                for (int s = 0; s < SC; ++s) { const u32x2g w = sl[(size_t)(s0 + s) * (MS * DM / 4)]; t_[r][s] = (f32x4){pg8::bf_lo(w.x), pg8::bf_hi(w.x), pg8::bf_lo(w.y), pg8::bf_hi(w.y)}; } }
#pragma unroll
            for (int r = 0; r < 2; ++r) if (r == 0 || n2) {
#pragma unroll
                for (int s = 0; s < SC; ++s) a[r] += t_[r][s]; } } }
    float ss[2];
#pragma unroll
    for (int r = 0; r < 2; ++r) { ss[r] = 0.f; if (r == 0 || n2) { const int row = MP + rs0 + r * dr;
        if (MODE != 0) {
            if (MODE == 1) v[r] += a[r];
            else { a[r] = a[r] * rsi[r];
                v[r][0] += pg8::sigm(a[r][0]) * pg8::bf_lo(pw[r].x); v[r][1] += pg8::sigm(a[r][1]) * pg8::bf_hi(pw[r].x); v[r][2] += pg8::sigm(a[r][2]) * pg8::bf_lo(pw[r].y); v[r][3] += pg8::sigm(a[r][3]) * pg8::bf_hi(pw[r].y); }
            }
        ss[r] = (v[r][0] * v[r][0] + v[r][1] * v[r][1]) + (v[r][2] * v[r][2] + v[r][3] * v[r][3]); } }
#pragma unroll
    for (int o = 1; o < 64; o <<= 1) { ss[0] += shx(ss[0], o, lane); ss[1] += shx(ss[1], o, lane); }
    LAS float* rd = red + 16 * (parity & 1);
    if (lane == 0) { rd[wave] = ss[0]; rd[8 + wave] = ss[1]; }
    __syncthreads();
#pragma unroll
    for (int r = 0; r < 2; ++r) if (r == 0 || n2) { const int row = MP + rs0 + r * dr; float tot = 0.f;
#pragma unroll
        for (int w = 0; w < 8; ++w) tot += rd[8 * r + w];
        if (OUTF32) { const float rstd = 1.0f / sqrtf(tot * (1.f / DM) + EPS); const f32x4 g = ((const f32x4*)gain)[q]; ((f32x4*)(outf + (size_t)row * DM))[q] = v[r] * rstd * g; }
        else { const unsigned long long w = (unsigned long long)pk2(v[r][0], v[r][1]) | ((unsigned long long)pk2(v[r][2], v[r][3]) << 32);
            __hip_atomic_store((unsigned long long*)(HB + (size_t)row * DM) + q, w, __ATOMIC_RELAXED, __HIP_MEMORY_SCOPE_AGENT); if (wave == 0 && lane == 0) pg8::ss_store(SSo + row, tot); } }
}
__device__ __forceinline__ void conv_row(int l, int row, const bf16* z, const float* cache_conv, const float* conv_w, const float* conv_b, const float* ln_g, const float* ln_b, bf16* ya, float* out, int lane) {
    const bool samp = row >= MP; const int b = samp ? (row - MP) >> 5 : row >> 12, t = samp ? (row - MP) & 31 : row & 4095;
    float acc[2][8];
#pragma unroll
    for (int hh = 0; hh < 2; ++hh) load8f(conv_b + hh * 512 + 8 * lane, acc[hh]);
    for (int j = 0; j < CONVW; ++j) {
        const int tt = t - 30 + j;
        if (tt < 0 && !samp) continue;
#pragma unroll
        for (int hh = 0; hh < 2; ++hh) {
            const int c = hh * 512 + 8 * lane; float a[8], w[8];
            if (tt >= 0) { const bf16* zr = z + (size_t)(row - 30 + j) * ZP + ZA + c; float x[8], g[8]; unpack8(*(const v4u*)zr, x); unpack8(*(const v4u*)(zr + CONVD), g);
#pragma unroll
                for (int i = 0; i < 8; ++i) a[i] = x[i] * pg8::sigm(g[i]);
            } else load8f(cache_conv + (((size_t)l * DBATCH + b) * 30 + (30 + tt)) * CONVD + c, a);
            load8f(conv_w + (size_t)j * CONVD + c, w);
#pragma unroll
            for (int i = 0; i < 8; ++i) acc[hh][i] += a[i] * w[i];
            if (j == CONVW - 1) {
                if (!samp && t >= SEQ - 30) store8f(out + O_CSP + (((size_t)l * PBATCH + b) * 30 + (t - (SEQ - 30))) * CONVD + c, a);
                if (samp && t >= 2) store8f(out + O_CSS + (((size_t)l * DBATCH + b) * 30 + (t - 2)) * CONVD + c, a);
            }
        }
    }
    float s = 0.f;
#pragma unroll
    for (int hh = 0; hh < 2; ++hh)
#pragma unroll
        for (int i = 0; i < 8; ++i) s += acc[hh][i];
    const float mean = wave_sum(s, lane) * (1.f / CONVD); float q = 0.f;
#pragma unroll
    for (int hh = 0; hh < 2; ++hh)
#pragma unroll
        for (int i = 0; i < 8; ++i) { acc[hh][i] -= mean; q += acc[hh][i] * acc[hh][i]; }
    const float rstd = 1.0f / sqrtf(wave_sum(q, lane) * (1.f / CONVD) + EPS);
#pragma unroll
    for (int hh = 0; hh < 2; ++hh) { const int c = hh * 512 + 8 * lane; float g[8], bb[8], y[8]; load8f(ln_g + c, g); load8f(ln_b + c, bb);
#pragma unroll
        for (int i = 0; i < 8; ++i) { const float v = acc[hh][i] * rstd * g[i] + bb[i]; y[i] = v * pg8::sigm(v); }
        *(v4u*)(ya + (size_t)row * CONVD + c) = pack8(y); }
}
__device__ __forceinline__ void gmlp_v_row(int l, int row, const bf16* z, const float* ln_g, const float* ln_b, bf16* vb, float* out, int lane) {
    float x[2][8], g[2][8], bb[2][8]; float s = 0.f; v4u xr[2];
#pragma unroll
    for (int hh = 0; hh < 2; ++hh) { const int c = hh * 512 + 8 * lane; xr[hh] = *(const v4u*)(z + (size_t)row * ZP + ZB + GMD + c); load8f(ln_g + c, g[hh]); load8f(ln_b + c, bb[hh]); }
#pragma unroll
    for (int hh = 0; hh < 2; ++hh) { unpack8(xr[hh], x[hh]);
#pragma unroll
        for (int i = 0; i < 8; ++i) { x[hh][i] = gelu_tanh(x[hh][i]); s += x[hh][i]; } }
    const float mean = wave_sum(s, lane) * (1.f / GMD); float q = 0.f;
#pragma unroll
    for (int hh = 0; hh < 2; ++hh)
#pragma unroll
        for (int i = 0; i < 8; ++i) { x[hh][i] -= mean; q += x[hh][i] * x[hh][i]; }
    const float rstd = 1.0f / sqrtf(wave_sum(q, lane) * (1.f / GMD) + EPS);
#pragma unroll
    for (int hh = 0; hh < 2; ++hh) { const int c = hh * 512 + 8 * lane; float y[8];
#pragma unroll
        for (int i = 0; i < 8; ++i) y[i] = x[hh][i] * rstd * g[hh][i] + bb[hh][i];
        *(v4u*)(vb + (size_t)row * GMD + c) = pack8(y);
        if (row >= MP) store8f(out + O_GV + ((size_t)l * MS + (row - MP)) * GMD + c, y); }
}
__device__ __forceinline__ void gmlp_v_rows(int l, int row0, int stride, int nrows, const bf16* z, const float* ln_g, const float* ln_b, bf16* vb, float* out, int lane) {
    if (row0 >= nrows) return;
    float g[2][8], bb[2][8]; v4u xr[2], xn[2];
#pragma unroll
    for (int hh = 0; hh < 2; ++hh) { const int c = hh * 512 + 8 * lane; xr[hh] = *(const v4u*)(z + (size_t)row0 * ZP + ZB + GMD + c); load8f(ln_g + c, g[hh]); load8f(ln_b + c, bb[hh]); }
    for (int row = row0; row < nrows; row += stride) {
        const bool more = row + stride < nrows; const int nx = more ? row + stride : row;
#pragma unroll
        for (int hh = 0; hh < 2; ++hh) xn[hh] = *(const v4u*)(z + (size_t)nx * ZP + ZB + GMD + hh * 512 + 8 * lane);
        float x[2][8]; float s = 0.f;
#pragma unroll
        for (int hh = 0; hh < 2; ++hh) { unpack8(xr[hh], x[hh]);
#pragma unroll
            for (int i = 0; i < 8; ++i) { x[hh][i] = gelu_tanh(x[hh][i]); s += x[hh][i]; } }
        const float mean = wave_sum(s, lane) * (1.f / GMD); float q = 0.f;
#pragma unroll
        for (int hh = 0; hh < 2; ++hh)
#pragma unroll
            for (int i = 0; i < 8; ++i) { x[hh][i] -= mean; q += x[hh][i] * x[hh][i]; }
        const float rstd = 1.0f / sqrtf(wave_sum(q, lane) * (1.f / GMD) + EPS);
#pragma unroll
        for (int hh = 0; hh < 2; ++hh) { const int c = hh * 512 + 8 * lane; float y[8];
#pragma unroll
            for (int i = 0; i < 8; ++i) y[i] = x[hh][i] * rstd * g[hh][i] + bb[hh][i];
            *(v4u*)(vb + (size_t)row * GMD + c) = pack8(y);
            if (row >= MP) store8f(out + O_GV + ((size_t)l * MS + (row - MP)) * GMD + c, y); }
        xr[0] = xn[0]; xr[1] = xn[1];
    }
}
__device__ __forceinline__ void gmlp_spatial_row(int row, const bf16* z, const bf16* vb, const float* ws, const float* bs, bf16* yb, int lane) {
    const bool samp = row >= MP; const int t = samp ? (row - MP) & 31 : row & 4095; const int tl = samp ? t : (t & 127); const int chunk0 = row - tl;
    float acc[2][8];
#pragma unroll
    for (int hh = 0; hh < 2; ++hh)
#pragma unroll
        for (int i = 0; i < 8; ++i) acc[hh][i] = 0.f;
    const int g0 = lane >> 4;
    for (int s = 0; s <= tl; ++s) {
#pragma unroll
        for (int hh = 0; hh < 2; ++hh) { const int c = hh * 512 + 8 * lane; const float w = ws[((size_t)(hh * 4 + g0) * 128 + tl) * 128 + s]; float v[8]; unpack8(*(const v4u*)(vb + (size_t)(chunk0 + s) * GMD + c), v);
#pragma unroll
            for (int i = 0; i < 8; ++i) acc[hh][i] += w * v[i]; }
    }
#pragma unroll
    for (int hh = 0; hh < 2; ++hh) { const int c = hh * 512 + 8 * lane; const float bias = bs[(hh * 4 + g0) * 128 + tl]; float u[8], y[8]; unpack8(*(const v4u*)(z + (size_t)row * ZP + ZB + c), u);
#pragma unroll
        for (int i = 0; i < 8; ++i) y[i] = gelu_tanh(u[i]) * (acc[hh][i] + bias);
        *(v4u*)(yb + (size_t)row * GMD + c) = pack8(y); }
}
__device__ __forceinline__ void attn_task(int l, int row, int hh, const bf16* z, const float* ck, const float* cv, const float* tab, bf16* o, int lane) {
    const float scale = 0.08838834764831845f;
    const unsigned qw = *(const unsigned*)(z + (size_t)row * ZP + ZQ + hh * HDIM + 2 * lane);
    const float q0 = pg8::bf_lo(qw) * scale, q1 = pg8::bf_hi(qw) * scale;
    float m = -3.0e38f, lsum = 0.f, o0 = 0.f, o1 = 0.f;
    const float* tb = tab + hh * 257;
    const int col = hh * HDIM + 2 * lane;
    if (row < MP) {
        const int b = row >> 12, t = row & 4095, n = t >> 6;
        int p0 = (n - 8) * 64; if (p0 < 0) p0 = 0; const int p1 = n * 64 + 64;
        for (int p = p0; p < p1; ++p) {
            const bf16* kr = z + (size_t)(b * SEQ + p) * ZP;
            const unsigned kw = *(const unsigned*)(kr + ZK + col), vw = *(const unsigned*)(kr + ZV + col);
            float s = wave_sum(q0 * pg8::bf_lo(kw) + q1 * pg8::bf_hi(kw), lane);
            int rel = t - p; rel = rel < -128 ? -128 : (rel > 128 ? 128 : rel);
            s += tb[rel + 128];
            const float mn = fmaxf(m, s), corr = __expf(m - mn), pe = __expf(s - mn);
            lsum = lsum * corr + pe; o0 = o0 * corr + pe * pg8::bf_lo(vw); o1 = o1 * corr + pe * pg8::bf_hi(vw); m = mn;
        }
    } else {
        const int b = (row - MP) >> 5, t = (row - MP) & 31;
        for (int kidx = 0; kidx < WCACHE + DSEQ; ++kidx) {
            float k0, k1, v0, v1;
            if (kidx < WCACHE) { const size_t off = ((((size_t)l * DBATCH + b) * WCACHE + kidx) * NHEAD + hh) * HDIM + 2 * lane;
                const f32x2g kk = *(const f32x2g*)(ck + off), vv = *(const f32x2g*)(cv + off); k0 = kk.x; k1 = kk.y; v0 = vv.x; v1 = vv.y; }
            else { const bf16* kr = z + (size_t)(MP + b * DSEQ + (kidx - WCACHE)) * ZP; const unsigned kw = *(const unsigned*)(kr + ZK + col), vw = *(const unsigned*)(kr + ZV + col);
                k0 = pg8::bf_lo(kw); k1 = pg8::bf_hi(kw); v0 = pg8::bf_lo(vw); v1 = pg8::bf_hi(vw); }
            float s = wave_sum(q0 * k0 + q1 * k1, lane);
            int rel = t + WCACHE - kidx; rel = rel < -128 ? -128 : (rel > 128 ? 128 : rel);
            s += tb[rel + 128];
            const float mn = fmaxf(m, s), corr = __expf(m - mn), pe = __expf(s - mn);
            lsum = lsum * corr + pe; o0 = o0 * corr + pe * v0; o1 = o1 * corr + pe * v1; m = mn;
        }
    }
    const float inv = 1.0f / lsum;
    *(unsigned*)(o + (size_t)row * ATD + col) = pk2(o0 * inv, o1 * inv);
}
__device__ __forceinline__ void kv_rows(int l, int row, const bf16* z, float* out, int lane) {
    const bool samp = row >= MP; size_t ko, vo;
    if (samp) { ko = O_KS + ((size_t)l * MS + (row - MP)) * ATD; vo = O_VS + ((size_t)l * MS + (row - MP)) * ATD; }
    else { const int b = row >> 12, t = row & 4095; if (t < SEQ - WCACHE) return; ko = O_KP + (((size_t)l * PBATCH + b) * WCACHE + (t - (SEQ - WCACHE))) * ATD; vo = O_VP + (((size_t)l * PBATCH + b) * WCACHE + (t - (SEQ - WCACHE))) * ATD; }
    v4u kq[2], vq[2];
#pragma unroll
    for (int hh = 0; hh < 2; ++hh) { const int c = hh * 512 + 8 * lane; kq[hh] = *(const v4u*)(z + (size_t)row * ZP + ZK + c); vq[hh] = *(const v4u*)(z + (size_t)row * ZP + ZV + c); }
#pragma unroll
    for (int hh = 0; hh < 2; ++hh) { const int c = hh * 512 + 8 * lane; float f[8];
        unpack8(kq[hh], f); store8f(out + ko + c, f);
        unpack8(vq[hh], f); store8f(out + vo + c, f); }
}
constexpr int CONV_R = 35, RUNS_PB = (SEQ + CONV_R - 1) / CONV_R, CONV_RUNS = PBATCH * RUNS_PB + DBATCH, CONV_WUNITS = CONV_RUNS * 8;
static_assert(CONV_WUNITS <= 2048, "one conv wave-unit per wave");
__device__ __forceinline__ f32x2g glu2w(unsigned x) { f32x2g a; a.x = pg8::bf_lo(x); a.y = pg8::bf_hi(x); return a; }
constexpr int CONV_G = 8;
__device__ __forceinline__ void conv_unit(int l, int wu, const bf16* Z, const float* cache_conv, const float* conv_w, const float* conv_b, float* Y, float* out, int lane) {
    const int run = wu >> 3, c = (wu & 7) * 128 + 2 * lane;
    const bool samp = run >= PBATCH * RUNS_PB;
    int b, t0, len;
    if (!samp) { b = run / RUNS_PB; t0 = (run % RUNS_PB) * CONV_R; len = SEQ - t0 < CONV_R ? SEQ - t0 : CONV_R; } else { b = run - PBATCH * RUNS_PB; t0 = 0; len = DSEQ; }
    const int row0 = samp ? MP + b * DSEQ : b * SEQ + t0;
    const bf16* zc = Z + (size_t)row0 * ZP + ZA + c;
    unsigned xq[CONV_G];
#pragma unroll
    for (int u = 0; u < CONV_G; ++u) { const int ii = u < len ? u : len - 1; xq[u] = *(const unsigned*)(zc + (size_t)ii * ZP); }
    f32x2g w[CONVW], win[CONVW - 1 + CONV_G];
    { const float* wp = conv_w + c;
#pragma unroll
      for (int j = 0; j < CONVW; ++j) { w[j] = *(const f32x2g*)wp; wp += CONVD; asm volatile("" : "+v"(wp)); } }
    const f32x2g bias = *(const f32x2g*)(conv_b + c);
    if (samp) {
#pragma unroll
        for (int j = 0; j < CONVW - 1; ++j) win[j] = *(const f32x2g*)(cache_conv + (((size_t)l * DBATCH + b) * 30 + j) * CONVD + c);
    } else if (t0 == 0) {
#pragma unroll
        for (int j = 0; j < CONVW - 1; ++j) win[j] = (f32x2g){0.f, 0.f};
    } else {
        unsigned xw[CONVW - 1];
#pragma unroll
        for (int j = 0; j < CONVW - 1; ++j) xw[j] = *(const unsigned*)(zc + ((ptrdiff_t)j - 30) * ZP);
#pragma unroll
        for (int j = 0; j < CONVW - 1; ++j) win[j] = glu2w(xw[j]);
    }
    for (int i0 = 0; i0 < len; i0 += CONV_G) {
        unsigned xn[CONV_G];
#pragma unroll
        for (int u = 0; u < CONV_G; ++u) { int ii = i0 + CONV_G + u; ii = ii < len ? ii : len - 1; xn[u] = *(const unsigned*)(zc + (size_t)ii * ZP); }
#pragma unroll
        for (int u = 0; u < CONV_G; ++u) win[CONVW - 1 + u] = glu2w(xq[u]);
#pragma unroll
        for (int u = 0; u < CONV_G; ++u) { const int i = i0 + u;
            if (i < len) { const int t = t0 + i, row = row0 + i;
                f32x2g y = bias;
#pragma unroll
                for (int j = 0; j < CONVW; ++j) y += win[u + j] * w[j];
                *(f32x2g*)(Y + (size_t)row * CONVD + c) = y;
                if (!samp && t >= SEQ - 30) *(f32x2g*)(out + O_CSP + (((size_t)l * PBATCH + b) * 30 + (t - (SEQ - 30))) * CONVD + c) = win[CONVW - 1 + u];
                if (samp && t >= 2) *(f32x2g*)(out + O_CSS + (((size_t)l * DBATCH + b) * 30 + (t - 2)) * CONVD + c) = win[CONVW - 1 + u]; } }
#pragma unroll
        for (int j = 0; j < CONVW - 1; ++j) win[j] = win[j + CONV_G];
#pragma unroll
        for (int u = 0; u < CONV_G; ++u) xq[u] = xn[u];
    }
}
__device__ __forceinline__ void conv_ln_row(int row, const float* Y, const float* ln_g, const float* ln_b, bf16* ya, int lane) {
    float x[2][8], g[2][8], bb[2][8]; float s = 0.f;
#pragma unroll
    for (int hh = 0; hh < 2; ++hh) { load8f(Y + (size_t)row * CONVD + hh * 512 + 8 * lane, x[hh]); load8f(ln_g + hh * 512 + 8 * lane, g[hh]); load8f(ln_b + hh * 512 + 8 * lane, bb[hh]); }
#pragma unroll
    for (int hh = 0; hh < 2; ++hh)
#pragma unroll
        for (int i = 0; i < 8; ++i) s += x[hh][i];
    const float mean = wave_sum(s, lane) * (1.f / CONVD); float q = 0.f;
#pragma unroll
    for (int hh = 0; hh < 2; ++hh)
#pragma unroll
        for (int i = 0; i < 8; ++i) { x[hh][i] -= mean; q += x[hh][i] * x[hh][i]; }
    const float rstd = 1.0f / sqrtf(wave_sum(q, lane) * (1.f / CONVD) + EPS);
#pragma unroll
    for (int hh = 0; hh < 2; ++hh) { const int c = hh * 512 + 8 * lane; float y[8];
#pragma unroll
        for (int i = 0; i < 8; ++i) { const float v = x[hh][i] * rstd * g[hh][i] + bb[hh][i]; y[i] = v * pg8::sigm(v); }
        *(v4u*)(ya + (size_t)row * CONVD + c) = pack8(y); }
}
__device__ __forceinline__ void conv_ln_rows(int rowb, int i0, int stride, int len, const float* Y, const float* ln_g, const float* ln_b, bf16* ya, int lane) {
    if (i0 >= len) return;
    float xr[2][8], xn[2][8], g[2][8], bb[2][8];
#pragma unroll
    for (int hh = 0; hh < 2; ++hh) { load8f(Y + (size_t)(rowb + i0) * CONVD + hh * 512 + 8 * lane, xr[hh]); load8f(ln_g + hh * 512 + 8 * lane, g[hh]); load8f(ln_b + hh * 512 + 8 * lane, bb[hh]); }
    for (int i = i0; i < len; i += stride) { const int row = rowb + i; const bool more = i + stride < len; const int nxr = more ? row + stride : row;
#pragma unroll
        for (int hh = 0; hh < 2; ++hh) load8f(Y + (size_t)nxr * CONVD + hh * 512 + 8 * lane, xn[hh]);
        float x[2][8]; float s = 0.f;
#pragma unroll
        for (int hh = 0; hh < 2; ++hh)
#pragma unroll
            for (int k = 0; k < 8; ++k) { x[hh][k] = xr[hh][k]; s += x[hh][k]; }
        const float mean = wave_sum(s, lane) * (1.f / CONVD); float q = 0.f;
#pragma unroll
        for (int hh = 0; hh < 2; ++hh)
#pragma unroll
            for (int k = 0; k < 8; ++k) { x[hh][k] -= mean; q += x[hh][k] * x[hh][k]; }
        const float rstd = 1.0f / sqrtf(wave_sum(q, lane) * (1.f / CONVD) + EPS);
#pragma unroll
        for (int hh = 0; hh < 2; ++hh) { const int c = hh * 512 + 8 * lane; float y[8];
#pragma unroll
            for (int k = 0; k < 8; ++k) { const float v = x[hh][k] * rstd * g[hh][k] + bb[hh][k]; y[k] = v * pg8::sigm(v); }
            *(v4u*)(ya + (size_t)row * CONVD + c) = pack8(y); }
#pragma unroll
        for (int hh = 0; hh < 2; ++hh)
#pragma unroll
            for (int k = 0; k < 8; ++k) xr[hh][k] = xn[hh][k];
    }
}
namespace att {
using bf16x8 = __attribute__((ext_vector_type(8))) short;
using s16x4  = __attribute__((ext_vector_type(4))) short;
using f32x16 = __attribute__((ext_vector_type(16))) float;
using u32x4  = __attribute__((ext_vector_type(4))) unsigned;
constexpr float SCALE = 0.088388347648318440f, INV_SCALE = 11.313708498984761f, THR = 8.f;
constexpr int SHM_T = 16384;
constexpr int LDS_V = 0, LDS_K = 2 * SHM_T, LDS_WS = 4 * SHM_T, LDS_TAB = LDS_WS + 8 * 256, LDS_END = LDS_TAB + 1040;
#define KSWZ(row, colB) ((row) * 256 + ((colB) ^ (((row) & 7) << 4)))
#define SBAR() __builtin_amdgcn_sched_barrier(0)
__device__ __forceinline__ int crow(int r, int hi) { return (r & 3) + 8 * (r >> 2) + 4 * hi; }
__device__ __forceinline__ unsigned cvtpk(float lo, float hi) { unsigned r; asm volatile("v_cvt_pk_bf16_f32 %0, %1, %2" : "=v"(r) : "v"(lo), "v"(hi)); return r; }
__device__ __forceinline__ void partialSM(f32x16& p0, f32x16& p1, float& m_reg, float& mn, float& alpha) {
  constexpr float C = SCALE * 1.4426950408889634f;
  float pmax = p0[0];
#pragma unroll
  for (int r = 1; r < 16; ++r) pmax = fmaxf(pmax, p0[r]);
#pragma unroll
  for (int r = 0; r < 16; ++r) pmax = fmaxf(pmax, p1[r]);
  { auto rr = __builtin_amdgcn_permlane32_swap(__float_as_uint(pmax), __float_as_uint(pmax), false, false);
    pmax = fmaxf(__uint_as_float(rr[0]), __uint_as_float(rr[1])); }
  if (__builtin_expect(__all(pmax - m_reg <= THR / SCALE), 1)) { mn = m_reg; alpha = 1.f; }
  else { mn = fmaxf(m_reg, pmax); alpha = __builtin_amdgcn_exp2f((m_reg - mn) * C); m_reg = mn; }
  const float mnC = -mn * C;
#pragma unroll
  for (int r = 0; r < 16; ++r) p0[r] = fmaf(p0[r], C, mnC);
#pragma unroll
  for (int r = 0; r < 16; ++r) p1[r] = fmaf(p1[r], C, mnC);
#pragma unroll
  for (int r = 0; r < 16; ++r) p0[r] = __builtin_amdgcn_exp2f(p0[r]);
}
__device__ __forceinline__ void finishSM(f32x16& p0, f32x16& p1, float alpha, float& l_reg, bf16x8& pa0, bf16x8& pa1, bf16x8& pa2, bf16x8& pa3) {
#pragma unroll
  for (int r = 0; r < 16; ++r) p1[r] = __builtin_amdgcn_exp2f(p1[r]);
  float ps = 0;
#pragma unroll
  for (int r = 0; r < 16; ++r) ps += p0[r];
#pragma unroll
  for (int r = 0; r < 16; ++r) ps += p1[r];
  { auto rr = __builtin_amdgcn_permlane32_swap(__float_as_uint(ps), __float_as_uint(ps), false, false);
    ps = __uint_as_float(rr[0]) + __uint_as_float(rr[1]); }
  l_reg = l_reg * alpha + ps;
#define PK4(P, BASE, OUT) do { unsigned a0 = cvtpk(P[BASE + 0], P[BASE + 1]), a1 = cvtpk(P[BASE + 2], P[BASE + 3]);   \
    unsigned b0 = cvtpk(P[BASE + 4], P[BASE + 5]), b1 = cvtpk(P[BASE + 6], P[BASE + 7]);                              \
    auto r0 = __builtin_amdgcn_permlane32_swap(a0, b0, false, false); auto r1 = __builtin_amdgcn_permlane32_swap(a1, b1, false, false); \
    u32x4 w = {r0[0], r1[0], r0[1], r1[1]}; OUT = *reinterpret_cast<bf16x8*>(&w); } while (0)
  PK4(p0, 0, pa0); PK4(p0, 8, pa1); PK4(p1, 0, pa2); PK4(p1, 8, pa3);
#undef PK4
}
__device__ __forceinline__ void qkt(f32x16& p0, f32x16& p1, const char* Ks, const bf16x8* qr, int r32, int hi) {
  p0 = f32x16{}; p1 = f32x16{};
#pragma unroll
  for (int d0 = 0; d0 < 8; ++d0) { const int cb = (d0 * 16 + hi * 8) * 2;
    const bf16x8 b0 = *reinterpret_cast<const bf16x8*>(Ks + KSWZ(r32, cb));
    const bf16x8 b1 = *reinterpret_cast<const bf16x8*>(Ks + KSWZ(32 + r32, cb));
    p0 = __builtin_amdgcn_mfma_f32_32x32x16_bf16(b0, qr[d0], p0, 0, 0, 0);
    p1 = __builtin_amdgcn_mfma_f32_32x32x16_bf16(b1, qr[d0], p1, 0, 0, 0); }
}
__device__ __forceinline__ int v_st(int k, int c) { const int kk = (k & ~0xC) | ((k & 4) << 1) | ((k & 8) >> 1); return ((kk >> 3) * 4 + (c >> 5)) * 512 + ((kk & 7) * 32 + (c & 31)) * 2; }
__device__ __forceinline__ int v_rd_base(int lane) { return ((lane & 3) << 3) | (((lane >> 2) & 3) << 6) | (((lane >> 4) & 1) << 5) | (((lane >> 5) & 1) << 8); }
constexpr int v_rd_off(int d0, int ks, int half) { return d0 * 512 + ks * 4096 + half * 2048; }
template <int OFF> __device__ __forceinline__ s16x4 tr_read(int vb) { s16x4 r; asm volatile("ds_read_b64_tr_b16 %0, %1 offset:%2" : "=&v"(r) : "v"(vb), "i"(OFF) : "memory"); return r; }
template <int D0> __device__ __forceinline__ void pv_one(f32x16& od, int vb, bf16x8 pa0, bf16x8 pa1, bf16x8 pa2, bf16x8 pa3) {
  const s16x4 l0 = tr_read<v_rd_off(D0, 0, 0)>(vb), h0 = tr_read<v_rd_off(D0, 0, 1)>(vb), l1 = tr_read<v_rd_off(D0, 1, 0)>(vb), h1 = tr_read<v_rd_off(D0, 1, 1)>(vb);
  const s16x4 l2 = tr_read<v_rd_off(D0, 2, 0)>(vb), h2 = tr_read<v_rd_off(D0, 2, 1)>(vb), l3 = tr_read<v_rd_off(D0, 3, 0)>(vb), h3 = tr_read<v_rd_off(D0, 3, 1)>(vb);
  asm volatile("s_waitcnt lgkmcnt(0)" ::: "memory"); SBAR();
#define PK(L, H) (bf16x8){L[0], L[1], L[2], L[3], H[0], H[1], H[2], H[3]}
  od = __builtin_amdgcn_mfma_f32_32x32x16_bf16(pa0, PK(l0, h0), od, 0, 0, 0);
  od = __builtin_amdgcn_mfma_f32_32x32x16_bf16(pa1, PK(l1, h1), od, 0, 0, 0);
  od = __builtin_amdgcn_mfma_f32_32x32x16_bf16(pa2, PK(l2, h2), od, 0, 0, 0);
  od = __builtin_amdgcn_mfma_f32_32x32x16_bf16(pa3, PK(l3, h3), od, 0, 0, 0);
#undef PK
}
__device__ __forceinline__ void pv_d0(f32x16* o, int vb, bf16x8 pa0, bf16x8 pa1, bf16x8 pa2, bf16x8 pa3) {
  pv_one<0>(o[0], vb, pa0, pa1, pa2, pa3); pv_one<1>(o[1], vb, pa0, pa1, pa2, pa3); pv_one<2>(o[2], vb, pa0, pa1, pa2, pa3); pv_one<3>(o[3], vb, pa0, pa1, pa2, pa3);
}
__device__ __forceinline__ bf16x8 ld8_bf(const unsigned short* p) { return *reinterpret_cast<const bf16x8*>(p); }
__device__ __forceinline__ bf16x8 ld8_f32(const float* p) { const f32x4 a = *(const f32x4*)p, b = *(const f32x4*)(p + 4);
  u32x4 w = {cvtpk(a[0], a[1]), cvtpk(a[2], a[3]), cvtpk(b[0], b[1]), cvtpk(b[2], b[3])}; return *reinterpret_cast<bf16x8*>(&w); }

constexpr int PART_O = 32 * 128, PART_STRIDE = PART_O + 64;
__device__ __forceinline__ void attn_unit(int l, int u, const unsigned short* Z, const float* ck, const float* cv, const float* tab_l, unsigned short* OB, float* PART, char* lds) {
  int tid_ = threadIdx.x; asm volatile("" : "+v"(tid_));
  const int tid = tid_, wid = __builtin_amdgcn_readfirstlane(tid >> 6), lane = tid & 63, r32 = lane & 31, hi = lane >> 5;
  const bool samp = u >= 256;
  const int b = samp ? (u - 256) >> 4 : u >> 7, h = samp ? ((u - 256) >> 1) & 7 : (u >> 4) & 7, c0 = samp ? 0 : (u & 15) * 4, half = samp ? (u - 256) & 1 : 0;
  char* V_lds = lds + LDS_V; char* K_lds = lds + LDS_K;
  float* wsf = (float*)(lds + LDS_WS) + wid * 64; float* li_l = wsf; float* al_l = wsf + 32; float* btab = (float*)(lds + LDS_TAB);
  const float tabraw = tab_l[h * 257 + (tid < 257 ? tid : 256)];
  const int row0 = samp ? MP + b * DSEQ : b * SEQ + c0 * 64;
  const bool active = samp ? (wid == 0) : true;
  const int myc = c0 + (wid >> 1);
  const int tq0 = samp ? WCACHE : c0 * 64 + wid * 32;
  att::bf16x8 qr[8];
  { const unsigned short* Qw = Z + (size_t)(row0 + (samp ? 0 : wid * 32) + r32) * ZP + ZQ + h * HDIM + hi * 8;
#pragma unroll
    for (int d0 = 0; d0 < 8; ++d0) qr[d0] = ld8_bf(Qw + d0 * 16); }
  const int t_lo = samp ? 5 * half : (c0 >= 8 ? c0 - 8 : 0), nt = samp ? 5 - half : c0 + 4 - t_lo;
  const int sr = tid >> 4, sc = (tid & 15) * 8, vst0 = v_st(sr, sc), vst1 = v_st(32 + sr, sc);
  const int vb0 = (int)(uintptr_t)V_lds + v_rd_base(lane);
  f32x4 ra[8];
#define TLOAD(R, t) do { const int t_ = (t); \
    if (!samp) { const unsigned short* kr = Z + (size_t)(b * SEQ + t_ * 64 + sr) * ZP + h * HDIM + sc; \
        R[0] = *(const f32x4*)(kr + ZK); R[1] = *(const f32x4*)(kr + (size_t)32 * ZP + ZK); R[2] = *(const f32x4*)(kr + ZV); R[3] = *(const f32x4*)(kr + (size_t)32 * ZP + ZV); } \
    else if (t_ < 8) { const size_t off = ((((size_t)l * DBATCH + b) * WCACHE + t_ * 64 + sr) * NHEAD + h) * HDIM + sc; const float* kp = ck + off; const float* vp = cv + off; \
        R[0] = *(const f32x4*)kp; R[1] = *(const f32x4*)(kp + 4); R[2] = *(const f32x4*)(kp + (size_t)32 * NHEAD * HDIM); R[3] = *(const f32x4*)(kp + (size_t)32 * NHEAD * HDIM + 4); \
        R[4] = *(const f32x4*)vp; R[5] = *(const f32x4*)(vp + 4); R[6] = *(const f32x4*)(vp + (size_t)32 * NHEAD * HDIM); R[7] = *(const f32x4*)(vp + (size_t)32 * NHEAD * HDIM + 4); } \
    else { const unsigned short* kr = Z + (size_t)(MP + b * DSEQ + sr) * ZP + h * HDIM + sc; \
        R[0] = *(const f32x4*)(kr + ZK); R[2] = *(const f32x4*)(kr + ZV); R[1] = (f32x4){0.f, 0.f, 0.f, 0.f}; R[3] = R[1]; } } while (0)
#define CVT8(A, B) ({ u32x4 w_ = {cvtpk(A[0], A[1]), cvtpk(A[2], A[3]), cvtpk(B[0], B[1]), cvtpk(B[2], B[3])}; *reinterpret_cast<bf16x8*>(&w_); })
#define TWRITE(R, bufi, t) do { const int bo_ = (bufi) * SHM_T; bf16x8 ks0, ks1, vs0, vs1; \
    if (samp && (t) < 8) { ks0 = CVT8(R[0], R[1]); ks1 = CVT8(R[2], R[3]); vs0 = CVT8(R[4], R[5]); vs1 = CVT8(R[6], R[7]); } \
    else { ks0 = __builtin_bit_cast(bf16x8, R[0]); ks1 = __builtin_bit_cast(bf16x8, R[1]); vs0 = __builtin_bit_cast(bf16x8, R[2]); vs1 = __builtin_bit_cast(bf16x8, R[3]); } \
    *(bf16x8*)(V_lds + bo_ + vst0) = vs0; *(bf16x8*)(V_lds + bo_ + vst1) = vs1; const int kc_ = sc * 2; \
    *(bf16x8*)(K_lds + bo_ + KSWZ(sr, kc_)) = ks0; *(bf16x8*)(K_lds + bo_ + KSWZ(32 + sr, kc_)) = ks1; } while (0)
#define RESC(a) do { if (__any((a) < 1.f)) { if (hi == 0) al_l[r32] = (a); asm volatile("s_waitcnt lgkmcnt(0)" ::: "memory"); \
    _Pragma("unroll") for (int d = 0; d < 4; ++d) _Pragma("unroll") for (int r = 0; r < 16; ++r) o[d][r] *= al_l[crow(r, hi)]; } } while (0)
  float m_reg = -1e30f, l_reg = 0.f; f32x16 o[4] = {};
  TLOAD(ra, t_lo);
  __syncthreads();
  if (tid < 257) btab[tid] = tabraw * INV_SCALE;
  for (int i = 0; i < nt; ++i) {
    const int t = t_lo + i, buf = i & 1;
    TWRITE(ra, buf, t);
    __syncthreads();
    if (i + 1 < nt) TLOAD(ra, t + 1);
    const bool mine = active && (samp || (t >= myc - 8 && t <= myc));
    if (mine) {
      f32x16 p0, p1; float mn, alpha; bf16x8 pa0, pa1, pa2, pa3;
      qkt(p0, p1, K_lds + buf * SHM_T, qr, r32, hi);
      const int rel0 = tq0 - t * 64;
      if (rel0 - 63 >= 128) { const float bc = btab[256];
#pragma unroll
        for (int r = 0; r < 16; ++r) { p0[r] += bc; p1[r] += bc; } }
      else { const int relq = rel0 + r32;
#pragma unroll
        for (int r = 0; r < 16; ++r) { int e0 = relq - crow(r, hi), e1 = e0 - 32;
          e0 = e0 < -128 ? -128 : (e0 > 128 ? 128 : e0); e1 = e1 < -128 ? -128 : (e1 > 128 ? 128 : e1);
          p0[r] += btab[e0 + 128]; p1[r] += btab[e1 + 128]; } }
      if (samp && t == 8) {
#pragma unroll
        for (int r = 0; r < 16; ++r) p1[r] = -1e30f; }
      partialSM(p0, p1, m_reg, mn, alpha);
      RESC(alpha);
      finishSM(p0, p1, alpha, l_reg, pa0, pa1, pa2, pa3); SBAR();
      pv_d0(o, vb0 + buf * SHM_T, pa0, pa1, pa2, pa3);
    }
  }
  if (active && samp) {
    float* P = PART + (size_t)((b * NHEAD + h) * 2 + half) * PART_STRIDE;
#pragma unroll
    for (int r = 0; r < 16; ++r) { const int orow = crow(r, hi);
#pragma unroll
      for (int d0 = 0; d0 < 4; ++d0) P[orow * 128 + d0 * 32 + r32] = o[d0][r]; }
    if (hi == 0) { P[PART_O + 2 * r32] = m_reg; P[PART_O + 2 * r32 + 1] = l_reg; }
  }
  if (active && !samp) {
    if (hi == 0) li_l[r32] = l_reg;
    asm volatile("s_waitcnt lgkmcnt(0)" ::: "memory");
    float rli[16];
#pragma unroll
    for (int r = 0; r < 16; ++r) rli[r] = __builtin_amdgcn_rcpf(li_l[crow(r, hi)]);
    unsigned short* Ow = OB + (size_t)(row0 + (samp ? 0 : wid * 32)) * ATD + h * HDIM;
#pragma unroll
    for (int r = 0; r < 16; ++r) { const int orow = crow(r, hi);
#pragma unroll
      for (int d0 = 0; d0 < 4; ++d0) Ow[(size_t)orow * ATD + d0 * 32 + r32] = (unsigned short)f2bf(o[d0][r] * rli[r]); }
  }
#undef TLOAD
#undef TWRITE
#undef CVT8
#undef RESC
}
__device__ __forceinline__ void attn_sample_combine(int task, const float* PART, unsigned short* OB, int lane) {
  const int p = task >> 5, t = task & 31, b = p >> 3, h = p & 7;
  const float* P0 = PART + (size_t)(p * 2) * PART_STRIDE; const float* P1 = P0 + PART_STRIDE;
  const float m0 = P0[PART_O + 2 * t], l0 = P0[PART_O + 2 * t + 1], m1 = P1[PART_O + 2 * t], l1 = P1[PART_O + 2 * t + 1];
  constexpr float C = SCALE * 1.4426950408889634f; const float m = fmaxf(m0, m1), w0 = __builtin_amdgcn_exp2f((m0 - m) * C), w1 = __builtin_amdgcn_exp2f((m1 - m) * C);
  const float inv = __builtin_amdgcn_rcpf(l0 * w0 + l1 * w1);
  const f32x2g a = *(const f32x2g*)(P0 + t * 128 + 2 * lane), c = *(const f32x2g*)(P1 + t * 128 + 2 * lane);
  *(unsigned*)(OB + (size_t)(MP + b * DSEQ + t) * ATD + h * HDIM + 2 * lane) = pk2((a.x * w0 + c.x * w1) * inv, (a.y * w0 + c.y * w1) * inv);
}
#undef KSWZ
#undef SBAR
}
namespace att {
template <int KS> __device__ __forceinline__ void gm_step(f32x16& o0, f32x16& o1, int vb, bf16x8 pa) {
  constexpr int TB = (KS >> 2) * SHM_T, KK = KS & 3;
  const s16x4 l0 = tr_read<TB + v_rd_off(0, KK, 0)>(vb), h0 = tr_read<TB + v_rd_off(0, KK, 1)>(vb), l1 = tr_read<TB + v_rd_off(1, KK, 0)>(vb), h1 = tr_read<TB + v_rd_off(1, KK, 1)>(vb);
  asm volatile("s_waitcnt lgkmcnt(0)" ::: "memory"); __builtin_amdgcn_sched_barrier(0);
#define PK(L, H) (bf16x8){L[0], L[1], L[2], L[3], H[0], H[1], H[2], H[3]}
  o0 = __builtin_amdgcn_mfma_f32_32x32x16_bf16(pa, PK(l0, h0), o0, 0, 0, 0);
  o1 = __builtin_amdgcn_mfma_f32_32x32x16_bf16(pa, PK(l1, h1), o1, 0, 0, 0);
#undef PK
}
__device__ __forceinline__ bf16x8 ws_frag(const f32x4 a, const f32x4 b, int s0, int t) {
  float f[8] = {a[0], a[1], a[2], a[3], b[0], b[1], b[2], b[3]};
#pragma unroll
  for (int j = 0; j < 8; ++j) f[j] = (s0 + j <= t) ? f[j] : 0.f;
  u32x4 w = {cvtpk(f[0], f[1]), cvtpk(f[2], f[3]), cvtpk(f[4], f[5]), cvtpk(f[6], f[7])}; return *reinterpret_cast<bf16x8*>(&w);
}
__device__ __forceinline__ void gm_unit(int u, const unsigned short* Z, const unsigned short* VB, const float* ws_l, const float* bs_l, unsigned short* YB, char* lds) {
  int tid_ = threadIdx.x; asm volatile("" : "+v"(tid_));
  const int tid = tid_, wid = __builtin_amdgcn_readfirstlane(tid >> 6), lane = tid & 63, r32 = lane & 31, hi = lane >> 5;
  const bool samp = u >= 512;
  const int g = samp ? (u - 512) & 7 : u & 7;
  const int chunk0 = samp ? MP + ((u - 512) >> 3) * DSEQ : (u >> 8) * SEQ + ((u >> 3) & 31) * 128;
  const int nrows = samp ? DSEQ : 128;
  const int sr = tid >> 4, sc = (tid & 15) * 8;
  bf16x8 vq[4];
#pragma unroll
  for (int q = 0; q < 4; ++q) { const int rr = (q >> 1) * 64 + (q & 1) * 32 + sr;
    vq[q] = bf16x8{}; if (rr < nrows) vq[q] = ld8_bf(VB + (size_t)(chunk0 + rr) * GMD + g * 128 + sc); }
  const int tb = wid >> 1, ch = wid & 1;
  const bool act = tb * 32 < nrows;
  const int t = tb * 32 + r32, nks = 2 * (tb + 1);
  f32x4 wa[8], wb[8]; unsigned short uq[16][2]; float bq[16];
  if (act) {
    const float* wrow = ws_l + ((size_t)g * 128 + t) * 128 + 8 * hi;
#pragma unroll
    for (int ks = 0; ks < 8; ++ks) { wa[ks] = (f32x4){0.f, 0.f, 0.f, 0.f}; wb[ks] = wa[ks]; if (ks < nks) { wa[ks] = *(const f32x4*)(wrow + 16 * ks); wb[ks] = *(const f32x4*)(wrow + 16 * ks + 4); } }
#pragma unroll
    for (int r = 0; r < 16; ++r) { const size_t row = (size_t)(chunk0 + tb * 32 + crow(r, hi)); bq[r] = bs_l[g * 128 + tb * 32 + crow(r, hi)];
#pragma unroll
      for (int dd = 0; dd < 2; ++dd) uq[r][dd] = Z[row * ZP + ZB + g * 128 + (2 * ch + dd) * 32 + r32]; }
  }
  __syncthreads();
#pragma unroll
  for (int q = 0; q < 4; ++q) *(bf16x8*)(lds + (q >> 1) * SHM_T + v_st((q & 1) * 32 + sr, sc)) = vq[q];
  __syncthreads();
  if (act) {
    f32x16 o0 = {}, o1 = {};
    const int vb = (int)(uintptr_t)lds + v_rd_base(lane) + ch * 1024;
#define GM_KS(KS) if (KS < nks) gm_step<KS>(o0, o1, vb, ws_frag(wa[KS], wb[KS], 16 * KS + 8 * hi, t));
    GM_KS(0) GM_KS(1) GM_KS(2) GM_KS(3) GM_KS(4) GM_KS(5) GM_KS(6) GM_KS(7)
#undef GM_KS
#pragma unroll
    for (int r = 0; r < 16; ++r) { const int trow = tb * 32 + crow(r, hi); const float bias = bq[r]; const size_t row = (size_t)(chunk0 + trow);
#pragma unroll
      for (int dd = 0; dd < 2; ++dd) { const int c = g * 128 + (2 * ch + dd) * 32 + r32;
        const float uu = __uint_as_float((unsigned)uq[r][dd] << 16);
        const float val = gelu_tanh(uu) * ((dd ? o1[r] : o0[r]) + bias);
        YB[row * GMD + c] = (unsigned short)f2bf(val); } }
  }
}
}
struct Args { const float* in[29]; float* out; unsigned char* ws; int ph_lo, ph_hi; };
constexpr int PH_PER_LAYER = 8, CW_CNT = 8192, N_PHASES = 1 + DEPTH * PH_PER_LAYER + 1;

typedef const __attribute__((address_space(4))) Args* KArgs;
#define PHASE_ENTER() KArgs ap = (KArgs)__builtin_amdgcn_kernarg_segment_ptr(); asm volatile("" : "+s"(ap)); \
    int tid = threadIdx.x; asm volatile("" : "+v"(tid)); \
    const int lane = tid & 63, wave = __builtin_amdgcn_readfirstlane(tid >> 6); \
    const int G = gridDim.x; const int vcu = (G % 8 == 0) ? ((int)blockIdx.x % 8) * (G / 8) + (int)blockIdx.x / 8 : (int)blockIdx.x; \
    const int gw = vcu * NWAVES + wave, NGW = G * NWAVES; unsigned char* const ws = ap->ws; float* const out = ap->out; \
    (void)lane; (void)gw; (void)NGW; (void)out; (void)ws
#define WSP(T, off) ((T*)(ws + (off)))

#ifndef PROBE_MASK
#define PROBE_MASK 0
#endif
#define REP(bit) for (int rep_ = 0; rep_ < 1 + ((PROBE_MASK >> (bit)) & 1); ++rep_)
__global__ void __launch_bounds__(NWAVES * 64, 2) enc_fwd(Args args) {
    extern __shared__ __attribute__((aligned(16))) unsigned char lds[];
    LAS unsigned char* const L = (LAS unsigned char*)lds;
    { const int tid0 = threadIdx.x;
      for (int u = tid0; u < (LDS_BYTES - LDSCTL_OFF) / 4; u += NWAVES * 64) ((LAS unsigned*)(L + LDSCTL_OFF))[u] = 0u; }
    __syncthreads();
    if (!MK_PER_PHASE) { (void)xcd_barrier_post((unsigned*)((gu32*)(args.ws + WS_CTL) + CW_BAR), (volatile LAS unsigned*)(L + MISC_OFF) + 8); }
    const int lo = args.ph_lo, hi = args.ph_hi;
#if defined(TLB_TOUCH)
    if (lo == 0) { const int idx_ = ((int)blockIdx.x >> 3) * (NWAVES * 64) + (int)threadIdx.x, str_ = ((int)gridDim.x >> 3) * (NWAVES * 64); unsigned acc_ = 0u;
#define TOUCH(base, bytes) for (size_t off_ = (size_t)idx_ << 21; off_ < (size_t)(bytes); off_ += (size_t)str_ << 21) acc_ += __builtin_nontemporal_load((const unsigned*)((const char*)(base) + off_))
        TOUCH(args.in[8], (size_t)DEPTH * DM * INC * 4); TOUCH(args.in[23], (size_t)DEPTH * DM * DFF * 4); TOUCH(args.in[24], (size_t)DEPTH * DM * DFF * 4); TOUCH(args.in[21], (size_t)DEPTH * DM * DM * 4); TOUCH(args.in[26], (size_t)DEPTH * DM * DM * 4);
        TOUCH(args.in[13], (size_t)DEPTH * CONVD * DM * 4); TOUCH(args.in[18], (size_t)DEPTH * CONVD * DM * 4); TOUCH(args.in[20], (size_t)DEPTH * CONVD * DM * 4); TOUCH(args.in[0], (size_t)MP * DM * 4); TOUCH(args.in[2], (size_t)DEPTH * MP * PLED * 4);
        TOUCH(args.in[5], (size_t)DEPTH * DBATCH * WCACHE * ATD * 4); TOUCH(args.in[6], (size_t)DEPTH * DBATCH * WCACHE * ATD * 4); TOUCH(args.ws, WS_END); TOUCH(args.out, O_END * 4);
#undef TOUCH
        if (acc_ == 0x9e3779b9u && threadIdx.x == 7777) __hip_atomic_store((gu32*)args.ws + 3, acc_, RLX_AGENT); }
#endif
#define IN(k) (lo <= (k) && (k) < hi)
#define SEAM(k) do { if (IN((k) + 1)) { if (MK_PER_PHASE) { if (threadIdx.x == 0) __hip_atomic_store((gu32*)ws, 0xBADBA0u, RLX_AGENT); } \
        else { XcdBarrier bar_; bar_.bar = (unsigned*)((gu32*)(ws + WS_CTL) + CW_BAR); bar_.x = xb_xcc_id(); bar_.st = (volatile LAS unsigned*)(L + MISC_OFF) + 8; REP(7) xcd_barrier(bar_); } } } while (0)

    for (int pass_ = 0; pass_ < 1 + ((PROBE_MASK >> 12) & 1); ++pass_) {
    if (IN(0)) {
        PHASE_ENTER();
        LAS float* scr = (LAS float*)(L + RING_OFF + wave * 16384);
        REP(0) {
        constexpr int I_IN = (DM / 64) * (INC / 256), I_BR = (CONVD / 64) * (DM / 256), I_O = (DM / 64) * (DM / 256), I_F1 = (DM / 64) * (DFF / 256), I_F2 = (DFF / 64) * (DM / 256), I_PG = I_O, I_PP = (PLED / 64) * (DM / 256);
        constexpr int I_LAYER = I_IN + 3 * I_BR + I_O + I_F1 + I_F2 + I_PG + I_PP;
#define P0_DESC(d, itv) do { d.gain = nullptr; d.glu = 0; const int l_ = (itv) / I_LAYER; int r_ = (itv) % I_LAYER; unsigned char* wl_ = ws + WS_WT + (size_t)l_ * WT_LAYER; \
            if (r_ < I_IN) { d.W = ap->in[8] + (size_t)l_ * DM * INC; d.K = DM; d.N = INC; d.WT = (bf16*)(wl_ + WT_IN); d.gain = ap->in[7] + (size_t)l_ * DM; d.glu = CONVD; } else { r_ -= I_IN; \
            if (r_ < I_BR) { d.W = ap->in[13] + (size_t)l_ * CONVD * DM; d.K = CONVD; d.N = DM; d.WT = (bf16*)(wl_ + WT_A); } else { r_ -= I_BR; \
            if (r_ < I_BR) { d.W = ap->in[18] + (size_t)l_ * GMD * DM; d.K = GMD; d.N = DM; d.WT = (bf16*)(wl_ + WT_B); } else { r_ -= I_BR; \
            if (r_ < I_BR) { d.W = ap->in[20] + (size_t)l_ * ATD * DM; d.K = ATD; d.N = DM; d.WT = (bf16*)(wl_ + WT_C); } else { r_ -= I_BR; \
            if (r_ < I_O) { d.W = ap->in[21] + (size_t)l_ * DM * DM; d.K = DM; d.N = DM; d.WT = (bf16*)(wl_ + WT_O); } else { r_ -= I_O; \
            if (r_ < I_F1) { d.W = ap->in[23] + (size_t)l_ * DM * DFF; d.K = DM; d.N = DFF; d.WT = (bf16*)(wl_ + WT_F1); d.gain = ap->in[22] + (size_t)l_ * DM; } else { r_ -= I_F1; \
            if (r_ < I_F2) { d.W = ap->in[24] + (size_t)l_ * DFF * DM; d.K = DFF; d.N = DM; d.WT = (bf16*)(wl_ + WT_F2); } else { r_ -= I_F2; \
            if (r_ < I_PG) { d.W = ap->in[26] + (size_t)l_ * DM * DM; d.K = DM; d.N = DM; d.WT = (bf16*)(wl_ + WT_PG); d.gain = ap->in[25] + (size_t)l_ * DM; } else { r_ -= I_PG; \
            d.W = ap->in[27] + (size_t)l_ * PLED * DM; d.K = PLED; d.N = DM; d.WT = (bf16*)(wl_ + WT_PP); } } } } } } } } d.r = r_; d.ldw = (d.K == DFF) ? LD_T : (d.K == DM ? LD2 : d.K); } while (0)
        { f32x4 va[8], vb[8]; float ga[8], gb[8], gc[8]; P0Item dc, d0, d1; int it = vcu; LAS float* T = (LAS float*)(L + RING_OFF); constexpr int TOT_ = DEPTH * I_LAYER;
          bool h0 = it < TOT_, h1 = it + G < TOT_;
          { const int i0_ = h0 ? it : TOT_ - 1; P0_DESC(d0, i0_); p0w_load(d0, va, ga, wave, lane); }
          { const int i1_ = h1 ? it + G : TOT_ - 1; P0_DESC(d1, i1_); p0w_load(d1, vb, gb, wave, lane); }
#define P0_STEP(VA, GA, DA, HA, ITN) do { p0w_store(VA, T, wave, lane); _Pragma("unroll") for (int i = 0; i < 8; ++i) gc[i] = GA[i]; __syncthreads(); dc = DA; HA = (ITN) < TOT_; \
              { const int in_ = HA ? (ITN) : TOT_ - 1; P0_DESC(DA, in_); p0w_load(DA, VA, GA, wave, lane); } p0w_flush(dc, gc, T, wave, lane); __syncthreads(); } while (0)
          for (;;) { if (!h0) break; P0_STEP(va, ga, d0, h0, it + 2 * G); if (!h1) break; P0_STEP(vb, gb, d1, h1, it + 3 * G); it += 2 * G; }
#undef P0_STEP
        }
#undef P0_DESC
        bf16* const PLEB = WSP(bf16, WS_PLE);
        for (int row = gw; row < MTOK; row += NGW) {
            const float* src = row < MP ? ap->in[0] + (size_t)row * DM : ap->in[1] + (size_t)(row - MP) * DM;
            const f32x4* s4 = (const f32x4*)src + lane; u32x2g* b4 = (u32x2g*)(WSP(bf16, WS_H) + (size_t)row * DM) + lane; float ss = 0.f;
            f32x4 vv_[8];
#pragma unroll
            for (int j = 0; j < 8; ++j) vv_[j] = s4[64 * j];
#pragma unroll
            for (int j = 0; j < 8; ++j) { const f32x4 v = vv_[j]; u32x2g w; w.x = pk2(v[0], v[1]); w.y = pk2(v[2], v[3]); b4[64 * j] = w; ss += (v[0] * v[0] + v[1] * v[1]) + (v[2] * v[2] + v[3] * v[3]); }
            ss = wave_sum(ss, lane); if (lane == 0) pg8::ss_store(WSP(pg8::ssq_t, WS_SS) + 2 * MTOK + row, ss);
        }
        for (int r0 = gw; r0 < DEPTH * MTOK; r0 += 4 * NGW) {
            f32x4 v_[4];
#pragma unroll
            for (int k = 0; k < 4; ++k) { const int r = r0 + k * NGW; if (r < DEPTH * MTOK) { const int l = r / MTOK, row = r % MTOK;
                const float* src = row < MP ? ap->in[2] + ((size_t)l * MP + row) * PLED : ap->in[3] + ((size_t)l * MS + (row - MP)) * PLED; v_[k] = ((const f32x4*)src)[lane]; } }
#pragma unroll
            for (int k = 0; k < 4; ++k) { const int r = r0 + k * NGW; if (r < DEPTH * MTOK) { const f32x4 v = v_[k]; u32x2g w; w.x = pk2(v[0], v[1]); w.y = pk2(v[2], v[3]); ((u32x2g*)(PLEB + (size_t)r * PLED))[lane] = w; } }
        }
        }
        SEAM(0);
    }

    for (int l = 0; l < DEPTH; ++l) {
        const int pb = 1 + l * PH_PER_LAYER;
#define WL(off) ((const bf16*)(ws + WS_WT + (size_t)l * WT_LAYER + (off)))
#define GEMM_CALL(EPI, Aptr, Bptr, NN, KK, ...) GEMM_CALL_LD(EPI, Aptr, Bptr, NN, KK, 0, 0, __VA_ARGS__)
#define GEMM_CALL_LD(EPI, Aptr, Bptr, NN, KK, LDA, LDB, ...) do { pg8::Gemm g_{Aptr, Bptr, MTOK, NN, KK, 0, 0, LDA, LDB}; pg8::StaticOrder S_; S_.init(MTOK, NN, KK, (int)gridDim.x, (int)blockIdx.x); EPI E_{__VA_ARGS__}; \
        pg8::gemm_phase<EPI, pg8::StaticOrder, PG8_ALIGN, PG8_SP2>(L + RING_OFF, g_, S_, E_); } while (0)
#define GEMM_SPLIT(EPI, Aptr, Bptr, NN, KK, SS, ...) GEMM_SPLIT_LD(EPI, Aptr, Bptr, NN, KK, 0, 0, SS, __VA_ARGS__)
#define GEMM_SPLIT_LD(EPI, Aptr, Bptr, NN, KK, LDA, LDB, SS, ...) do { pg8::Gemm g_{Aptr, Bptr, MTOK, NN, KK, 0, 0, LDA, LDB}; pg8::SplitOrder S_; S_.init(MP, NN, KK, SS, (int)gridDim.x, (int)blockIdx.x); EPI E_{__VA_ARGS__}; \
        pg8::gemm_phase<EPI, pg8::SplitOrder, PG8_ALIGN, PG8_SP2>(L + RING_OFF, g_, S_, E_); } while (0)
#define SSA (WSP(pg8::ssq_t, WS_SS))
#define SSB (WSP(pg8::ssq_t, WS_SS) + MTOK)
#define SSC (WSP(pg8::ssq_t, WS_SS) + 2 * MTOK)
#define HBA (WSP(bf16, WS_XN))
#define HBB (WSP(bf16, WS_H))
#define FIXSET(F0, FN) const int fn_ = ((int)gridDim.x == 256) ? (FN) : (int)gridDim.x, fj_ = (int)blockIdx.x - (((int)gridDim.x == 256) ? (F0) : 0)
#define FIX_ROWS(e, F0, FN, S, MODE, HIN, SSI, HBO, SSO) do { FIXSET(F0, FN); if (fj_ >= 0 && fj_ < fn_) { LAS float* red_ = (LAS float*)(L + RING_OFF); int par_ = 0; \
            for (int rs = fj_; rs < MS; rs += 2 * fn_, ++par_) sample_rows_fix<S, MODE, false>(rs, fn_, rs + fn_ < MS, par_, HIN, WSP(bf16, WS_SLAB), (WSP(bf16, WS_PP4) + (size_t)(l > 0 ? l - 1 : 0) * MTOK * DM), SSI, HBO, SSO, nullptr, nullptr, red_, wave, lane); \
            PUBLISH(e); } } while (0)
#define PUBLISH(e) do { asm volatile("s_waitcnt vmcnt(0)" ::: "memory"); __syncthreads();     \
            if (threadIdx.x == 0) (void)__hip_atomic_fetch_add((gu32*)(ws + WS_CTL) + CW_CNT + 64 * (l * 8 + (e)), 1u, RLX_AGENT); } while (0)
#define WAITALL(e, F0, FN) do { const int need = ((int)gridDim.x == 256) ? (FN) : (int)gridDim.x; if (threadIdx.x < 64) { gu32* cnt_ = (gu32*)(ws + WS_CTL) + CW_CNT + 64 * (l * 8 + (e)); unsigned sp_ = 0u; \
                while ((unsigned)__builtin_amdgcn_readfirstlane(__hip_atomic_load(cnt_, RLX_AGENT)) < (unsigned)(need)) { __builtin_amdgcn_s_sleep(2); \
                    if (++sp_ > (1u << 20)) { if (threadIdx.x == 0) __hip_atomic_store((gu32*)(ws + WS_CTL) + CW_BAR + XB_TMO, 1u, RLX_AGENT); break; } } \
                __builtin_amdgcn_fence(__ATOMIC_ACQUIRE, "agent"); asm volatile("s_waitcnt vmcnt(0)" ::: "memory"); } \
            __syncthreads(); } while (0)
        if (IN(pb + 0)) { PHASE_ENTER();
            if (l > 0) FIX_ROWS(0, 232, 24, 8, 2, HBA, SSB, HBB, SSC);
            REP(4) {
            { pg8::Gemm g_{HBB, WL(WT_IN), MP, INC, DM, 0, 0, 0, LD2}; pg8::StaticOrder S_; S_.init(MP, INC, DM, (int)gridDim.x, (int)blockIdx.x, 1); pg8::EpiZ E_{WSP(bf16, WS_Z), ZP, SSC, WSP(unsigned char, WS_G8), 3 * DM, ZG / 256, 2 * CONVD / 256};
              pg8::gemm_phase<pg8::EpiZ, pg8::StaticOrder, PG8_ALIGN, PG8_SP2>(L + RING_OFF, g_, S_, E_); }
            if (l > 0) WAITALL(0, 232, 24);
            { const int G_ = (int)gridDim.x, nb_ = (MP / 256) * (INC / 256) % G_;
              const bool sub_ = nb_ > 0 && nb_ < G_;
              if (!sub_ || (int)blockIdx.x >= nb_) { pg8::Gemm g_{HBB + (size_t)MP * DM, WL(WT_IN), MS, INC, DM, 0, 0, 0, LD2}; pg8::StaticOrder S_; S_.init(MS, INC, DM, sub_ ? G_ - nb_ : G_, sub_ ? (int)blockIdx.x - nb_ : (int)blockIdx.x, 2);
                  pg8::EpiZ E_{WSP(bf16, WS_Z) + (size_t)MP * ZP, ZP, SSC + MP, WSP(unsigned char, WS_G8) + (size_t)MP * 3 * DM, 3 * DM, ZG / 256, 2 * CONVD / 256};
                  pg8::gemm_phase<pg8::EpiZ, pg8::StaticOrder, PG8_ALIGN, PG8_SP2>(L + RING_OFF, g_, S_, E_); } }
            }
            SEAM(pb + 0); }
        if (IN(pb + 1)) { PHASE_ENTER(); const bf16* const Z = WSP(bf16, WS_Z);
            for (int i = gw * 64 + lane; i < 3 * MTOK; i += NGW * 64) pg8::ss_store(WSP(pg8::ssq_t, WS_SS) + i, 0.f);
            REP(2) {
            REP(14) for (int run = vcu; run < CONV_RUNS; run += G) {
                conv_unit(l, run * 8 + wave, Z, ap->in[4], ap->in[9] + (size_t)l * CONVW * CONVD, ap->in[10] + (size_t)l * CONVD, WSP(float, WS_MG), out, lane);
                asm volatile("s_waitcnt vmcnt(0)" ::: "memory"); __syncthreads();
                { const bool samp_ = run >= PBATCH * RUNS_PB; const int t0_ = samp_ ? 0 : (run % RUNS_PB) * CONV_R, len_ = samp_ ? DSEQ : (SEQ - t0_ < CONV_R ? SEQ - t0_ : CONV_R);
                  const int row0_ = samp_ ? MP + (run - PBATCH * RUNS_PB) * DSEQ : (run / RUNS_PB) * SEQ + t0_;
                  conv_ln_rows(row0_, wave, NWAVES, len_, WSP(float, WS_MG), ap->in[11] + (size_t)l * CONVD, ap->in[12] + (size_t)l * CONVD, WSP(bf16, WS_YA), lane); }
            }
            REP(15) gmlp_v_rows(l, gw, NGW, MTOK, Z, ap->in[14] + (size_t)l * GMD, ap->in[15] + (size_t)l * GMD, WSP(bf16, WS_V), out, lane);
            REP(15) for (int row = gw; row < MTOK; row += NGW) kv_rows(l, row, Z, out, lane);
            REP(16) for (int u = vcu; u < 512; u += G) att::attn_unit(l, u, Z, ap->in[5], ap->in[6], ap->in[19] + (size_t)l * NHEAD * 257, WSP(bf16, WS_O), WSP(float, WS_MG + 34 * MiB), (char*)lds);
            }
            SEAM(pb + 1); }
        if (IN(pb + 2)) { PHASE_ENTER();
            REP(3) {
            for (int task = gw; task < DBATCH * NHEAD * DSEQ; task += NGW) att::attn_sample_combine(task, WSP(float, WS_MG + 34 * MiB), WSP(bf16, WS_O), lane);
            for (int u = vcu; u < 640; u += G) att::gm_unit(u, WSP(bf16, WS_Z), WSP(bf16, WS_V), ap->in[16] + (size_t)l * 8 * 128 * 128, ap->in[17] + (size_t)l * 8 * 128, WSP(bf16, WS_YB), (char*)lds);
            }
            SEAM(pb + 2); }
        if (IN(pb + 3)) { PHASE_ENTER(); REP(6) {
            pg8::Gemm g_{WSP(bf16, WS_YA), WL(WT_A), MTOK, DM, CONVD, (size_t)(WS_YB - WS_YA), (size_t)(WT_B - WT_A)}; pg8::BranchOrder S_; S_.init(MP, DM, CONVD, 4, (int)gridDim.x, (int)blockIdx.x);
            pg8::EpiBranchFused E_{WSP(unsigned char, WS_G8), 3 * DM, WSP(bf16, WS_MERGED), DM, WSP(bf16, WS_SLAB), MP / 256};
            pg8::gemm_phase<pg8::EpiBranchFused, pg8::BranchOrder, PG8_ALIGN, PG8_SP2>(L + RING_OFF, g_, S_, E_); }
            SEAM(pb + 3); }
        if (IN(pb + 4)) { PHASE_ENTER();
            { FIXSET(128, 128); if (fj_ >= 0 && fj_ < fn_) {
            for (int rs = fj_; rs < MS; rs += fn_) { const int q = wave * 64 + lane; const u32x2g* sl = (const u32x2g*)(WSP(bf16, WS_SLAB) + (size_t)rs * DM) + q; f32x4 t_[12]; f32x4 a = (f32x4){0.f, 0.f, 0.f, 0.f};
#pragma unroll
                for (int s = 0; s < 12; ++s) { const u32x2g w_ = sl[(size_t)s * (MS * DM / 4)]; t_[s] = (f32x4){pg8::bf_lo(w_.x), pg8::bf_hi(w_.x), pg8::bf_lo(w_.y), pg8::bf_hi(w_.y)}; }
#pragma unroll
                for (int s = 0; s < 12; ++s) a += t_[s];
                const unsigned long long w = (unsigned long long)pk2(a[0], a[1]) | ((unsigned long long)pk2(a[2], a[3]) << 32);
                __hip_atomic_store((unsigned long long*)(WSP(bf16, WS_MERGED) + (size_t)(MP + rs) * DM) + q, w, __ATOMIC_RELAXED, __HIP_MEMORY_SCOPE_AGENT); }
            PUBLISH(1); } }
            { pg8::Gemm g_{WSP(bf16, WS_MERGED), WL(WT_O), MTOK, DM, DM, 0, 0, 0, LD2}; pg8::SplitOrder S_; S_.init(MP, DM, DM, 8, (int)gridDim.x, (int)blockIdx.x, 1); pg8::EpiResBf16Split E_{HBB, HBA, DM, WSP(bf16, WS_SLAB), MP / 256, SSA};
              pg8::gemm_phase<pg8::EpiResBf16Split, pg8::SplitOrder, PG8_ALIGN, PG8_SP2>(L + RING_OFF, g_, S_, E_); }
            WAITALL(1, 128, 128);
            { pg8::Gemm g_{WSP(bf16, WS_MERGED), WL(WT_O), MTOK, DM, DM, 0, 0, 0, LD2}; pg8::SplitOrder S_; S_.init(MP, DM, DM, 8, (int)gridDim.x, (int)blockIdx.x, 2); pg8::EpiResBf16Split E_{HBB, HBA, DM, WSP(bf16, WS_SLAB), MP / 256, SSA};
              pg8::gemm_phase<pg8::EpiResBf16Split, pg8::SplitOrder, PG8_ALIGN, PG8_SP2>(L + RING_OFF, g_, S_, E_); }
            SEAM(pb + 4); }
        if (IN(pb + 5)) { PHASE_ENTER();
            FIX_ROWS(2, 64, 192, 8, 1, HBB, nullptr, HBA, SSA);
            REP(5) {
            { pg8::Gemm g_{HBA, WL(WT_F1), MP, DFF, DM, 0, 0, 0, LD2}; pg8::StaticOrder S_; S_.init(MP, DFF, DM, (int)gridDim.x, (int)blockIdx.x); pg8::EpiBf16<1> E_{WSP(bf16, WS_T), LD_T, SSA};
              pg8::gemm_phase<pg8::EpiBf16<1>, pg8::StaticOrder, PG8_ALIGN, PG8_SP2>(L + RING_OFF, g_, S_, E_); }
            WAITALL(2, 64, 192);
            { pg8::Gemm g_{HBA + (size_t)MP * DM, WL(WT_F1), MS, DFF, DM, 0, 0, 0, LD2}; pg8::StaticOrder S_; S_.init(MS, DFF, DM, (int)gridDim.x, (int)blockIdx.x); pg8::EpiBf16<1> E_{WSP(bf16, WS_T) + (size_t)MP * LD_T, LD_T, SSA + MP};
              pg8::gemm_phase<pg8::EpiBf16<1>, pg8::StaticOrder, PG8_ALIGN, PG8_SP2>(L + RING_OFF, g_, S_, E_); }
            { const int G_ = (int)gridDim.x, nb_ = (MS / 256) * (DFF / 256) % G_;
              const bool sub_ = nb_ > 0 && nb_ < G_;
              if (!sub_ || (int)blockIdx.x >= nb_) { pg8::Gemm g_{WSP(bf16, WS_PLE) + (size_t)l * MTOK * PLED, WL(WT_PP), MTOK, DM, PLED}; pg8::StaticOrder S_; S_.init(MTOK, DM, PLED, sub_ ? G_ - nb_ : G_, sub_ ? (int)blockIdx.x - nb_ : (int)blockIdx.x);
                    pg8::EpiBf16<0> E_{WSP(bf16, WS_PP4) + (size_t)l * MTOK * DM, DM, nullptr};
                    pg8::gemm_phase<pg8::EpiBf16<0>, pg8::StaticOrder, PG8_ALIGN, PG8_SP2>(L + RING_OFF, g_, S_, E_); } } }
            SEAM(pb + 5); }
        if (IN(pb + 6)) { PHASE_ENTER(); GEMM_SPLIT_LD(pg8::EpiResBf16Split, WSP(bf16, WS_T), WL(WT_F2), DM, DFF, LD_T, LD_T, 16, HBA, HBA, DM, WSP(bf16, WS_SLAB), MP / 256, SSB);     SEAM(pb + 6); }
        if (IN(pb + 7)) { PHASE_ENTER();
            FIX_ROWS(3, 128, 128, 16, 1, HBA, nullptr, HBA, SSB);
            { pg8::Gemm g_{HBA, WL(WT_PG), MTOK, DM, DM, 0, 0, 0, LD2}; pg8::SplitOrder S_; S_.init(MP, DM, DM, 8, (int)gridDim.x, (int)blockIdx.x, 1);
              pg8::EpiPleBf16Split E_{HBA, HBB, WSP(bf16, WS_PP4) + (size_t)l * MTOK * DM, DM, WSP(bf16, WS_SLAB), MP / 256, SSB, SSC};
              pg8::gemm_phase<pg8::EpiPleBf16Split, pg8::SplitOrder, PG8_ALIGN, PG8_SP2>(L + RING_OFF, g_, S_, E_); }
            WAITALL(3, 128, 128);
            { pg8::Gemm g_{HBA, WL(WT_PG), MTOK, DM, DM, 0, 0, 0, LD2}; pg8::SplitOrder S_; S_.init(MP, DM, DM, 8, (int)gridDim.x, (int)blockIdx.x, 2);
              pg8::EpiPleBf16Split E_{HBA, HBB, WSP(bf16, WS_PP4) + (size_t)l * MTOK * DM, DM, WSP(bf16, WS_SLAB), MP / 256, SSB, SSC};
              pg8::gemm_phase<pg8::EpiPleBf16Split, pg8::SplitOrder, PG8_ALIGN, PG8_SP2>(L + RING_OFF, g_, S_, E_); }
            SEAM(pb + 7); }
    }
    if (IN(N_PHASES - 1)) { PHASE_ENTER(); LAS float* red_ = (LAS float*)(L + RING_OFF); int par_ = 0;
        for (int rs = vcu; rs < MS; rs += 2 * G, ++par_) sample_rows_fix<8, 2, true>(rs, G, rs + G < MS, par_, HBA, WSP(bf16, WS_SLAB), (WSP(bf16, WS_PP4) + (size_t)(DEPTH - 1) * MTOK * DM), SSB, nullptr, nullptr, ap->in[28], out, red_, wave, lane);
        rms_rows_bf16_to_f32(HBB, ap->in[28], out, gw, NGW, MP, lane);
        if (PROBE_MASK & 4096) { XcdBarrier bar_; bar_.bar = (unsigned*)((gu32*)(ws + WS_CTL) + CW_BAR); bar_.x = xb_xcc_id(); bar_.st = (volatile LAS unsigned*)(L + MISC_OFF) + 8; xcd_barrier(bar_); } }
    }
#undef IN
#undef SEAM
}

extern "C" void kernel_launch(void* const* d_in, const int* in_sizes, int n_in, void* d_out, int out_size, void* d_ws, size_t ws_size, hipStream_t stream) {
    static int grid = 0;
    if (grid == 0) {
        if (n_in != 29 || out_size != (int)O_END || ws_size < WS_END) { fprintf(stderr, "kernel_launch: unexpected shapes: n_in %d, out %d, ws %zu; nothing launched\n", n_in, out_size, ws_size); grid = -1; return; }
        int dev = 0, cus = 0, per_cu = 0;
        if (hipGetDevice(&dev) != hipSuccess || hipDeviceGetAttribute(&cus, hipDeviceAttributeMultiprocessorCount, dev) != hipSuccess) { fprintf(stderr, "kernel_launch: device query failed\n"); grid = -1; return; }
        if (hipFuncSetAttribute((const void*)enc_fwd, hipFuncAttributeMaxDynamicSharedMemorySize, LDS_BYTES) != hipSuccess) { fprintf(stderr, "kernel_launch: hipFuncSetAttribute failed\n"); grid = -1; return; }
        if (hipOccupancyMaxActiveBlocksPerMultiprocessor(&per_cu, (const void*)enc_fwd, NWAVES * 64, LDS_BYTES) != hipSuccess || per_cu < 1) { fprintf(stderr, "kernel_launch: occupancy query reports %d workgroups per CU\n", per_cu); }
        (void)hipGetLastError();
        grid = cus;
    }
    if (grid < 0) return;
    if (hipMemsetAsync((char*)d_ws + WS_CTL, 0, CTL_ZERO_BYTES, stream) != hipSuccess) { fprintf(stderr, "kernel_launch: memset failed\n"); return; }
    Args a{};
    for (int i = 0; i < 29; ++i) a.in[i] = (const float*)d_in[i];
    a.out = (float*)d_out; a.ws = (unsigned char*)d_ws;
#if MK_PER_PHASE
    for (int p = 0; p < N_PHASES; ++p) { a.ph_lo = p; a.ph_hi = p + 1; hipLaunchKernelGGL(enc_fwd, dim3(grid), dim3(NWAVES * 64), LDS_BYTES, stream, a); }
#else
    a.ph_lo = 0; a.ph_hi = N_PHASES;
    hipLaunchKernelGGL(enc_fwd, dim3(grid), dim3(NWAVES * 64), LDS_BYTES, stream, a);
#endif
    const hipError_t le = hipPeekAtLastError();
    if (le != hipSuccess) fprintf(stderr, "kernel_launch: launch failed: %s\n", hipGetErrorName(le));
}
```

```cpp
#include <hip/hip_runtime.h>
#include <cstdio>
#include <cstdint>
namespace pg8 {
#define PG8_LAS __attribute__((address_space(3)))
typedef unsigned short bf16_t;
typedef short bf16x8 __attribute__((ext_vector_type(8)));
typedef float f32x4 __attribute__((ext_vector_type(4)));
typedef unsigned u32x4 __attribute__((ext_vector_type(4)));
constexpr int BM = 256, BK = 64, HALF = 128, HTB = HALF * BK * 2  , STAGE_BYTES = 8 * HTB, NXCD = 8, WGM = 8;

__host__ __device__ __forceinline__ int lds_byte(int r, int c) { const int st = (r >> 4) * 2 + (c >> 5), rr = r & 15, cc = c & 31, ob = rr * 64 + cc * 2; return st * 1024 + (ob ^ (((ob >> 9) & 1) << 5)); }
__host__ __device__ __forceinline__ void stage_rc(int b, int& R, int& C) { const int st = b / 1024, sb = b % 1024, swz = sb ^ (((sb >> 9) & 1) << 5); R = (st >> 1) * 16 + swz / 64; C = (st & 1) * 32 + (swz % 64) / 2; }
__host__ __device__ __forceinline__ int perm32(int rho) { const int n = rho >> 4, i = rho & 15; return 8 * (i >> 2) + 4 * n + (i & 3); }

struct Unit { int pm, pn, k0, nt, ks, br, cont; };
struct Gemm { const bf16_t* A; const bf16_t* Bt; int M, N, K; size_t abr, bbr; int lda, ldb; };

__host__ __device__ __forceinline__ int permw52(int j) { const int h = j >= 26 ? 1 : 0, k = j - 26 * h; return k < 12 ? 28 + 12 * h + k : (k < 16 ? 4 * h + (k - 12) : 8 + 10 * h + (k - 16)); }
struct StaticOrder {
    int nM, nN, nwg, G, c, ntf, wperm;
    __host__ __device__ void init(int M, int N, int K, int G_, int c_, int wperm_ = 0) { nM = M / BM; nN = N / BM; nwg = nM * nN; G = G_; c = c_; ntf = K / BK; wperm = wperm_; }
    __host__ __device__ bool next(int i, Unit& u) const {
        const long L = (long)i * G + c; if (L >= nwg) return false;
        int wgid = (int)L; { const int q = nwg / NXCD, r = nwg % NXCD, xcd = wgid % NXCD, off = wgid / NXCD; wgid = (xcd < r ? xcd * (q + 1) : r * (q + 1) + (xcd - r) * q) + off; }
        const int nig = WGM * nN, gid = wgid / nig, fm = gid * WGM, gsz = (nM - fm) < WGM ? (nM - fm) : WGM;
        const int pn_ = (wgid % nig) / gsz; u.pm = fm + ((wgid % nig) % gsz); u.pn = wperm == 1 ? permw52(pn_) : (wperm == 2 ? (7 * pn_) % 52 : pn_);     u.k0 = 0; u.nt = ntf; u.ks = 0; u.br = 0; u.cont = 0; return true;
    }
    __device__ __forceinline__ void a_ready(const Unit&) const {}
    __device__ __forceinline__ void done(const Unit&) const {}
};
struct SplitOrder {
    StaticOrder P; int S, npt, part;
    __host__ __device__ void init(int Mp, int N, int K, int S_, int G_, int c_, int part_ = 0) { P.init(Mp, N, K, G_, c_); S = S_; npt = P.nwg; part = part_; }
    __host__ __device__ __forceinline__ bool next(int i, Unit& u) const {
        const long L = (long)i * P.G + P.c;
        const bool prompt = part != 2 && L < npt; const int j = part == 2 ? (int)L : (int)(L - npt);
        if (!prompt && (part == 1 || j >= 2 * P.nN * S)) return false;
        int pm, pn, k0 = 0, nt = P.ntf, ks = 0;
        if (prompt) { int wgid = (int)L; { const int q = P.nwg / NXCD, r = P.nwg % NXCD, xcd = wgid % NXCD, off = wgid / NXCD; wgid = (xcd < r ? xcd * (q + 1) : r * (q + 1) + (xcd - r) * q) + off; }
            const int nig = WGM * P.nN, gid = wgid / nig, fm = gid * WGM, gsz = (P.nM - fm) < WGM ? (P.nM - fm) : WGM;
            pm = fm + ((wgid % nig) % gsz); pn = (wgid % nig) / gsz; }
        else { const int tile = j / S; ks = j - tile * S; pm = P.nM + tile / P.nN; pn = tile % P.nN; nt = P.ntf / S; k0 = ks * nt * BK; }
        u.pm = pm; u.pn = pn; u.k0 = k0; u.nt = nt; u.ks = ks; u.br = 0; u.cont = 0; return true;
    }
    __device__ __forceinline__ void a_ready(const Unit&) const {}
    __device__ __forceinline__ void done(const Unit&) const {}
};
struct BranchOrder {
    StaticOrder P; int SB;
    __host__ __device__ void init(int Mp, int N, int K, int SB_, int G_, int c_) { P.init(Mp, N, K, G_, c_); SB = SB_; }
    __host__ __device__ __forceinline__ bool next(int i, Unit& u) const {
        const int nP = P.c < P.nwg ? (P.nwg - 1 - P.c) / P.G + 1 : 0;
        int pm, pn, k0 = 0, nt = P.ntf, ks = 0, br, cont = 0;
        if (i < 3 * nP) { br = i % 3; cont = br < 2 ? 1 : 0; int wgid = (i / 3) * P.G + P.c;
            { const int q = P.nwg / NXCD, r = P.nwg % NXCD, xcd = wgid % NXCD, off = wgid / NXCD; wgid = (xcd < r ? xcd * (q + 1) : r * (q + 1) + (xcd - r) * q) + off; }
            const int nig = WGM * P.nN, gid = wgid / nig, fm = gid * WGM, gsz = (P.nM - fm) < WGM ? (P.nM - fm) : WGM;
            pm = fm + ((wgid % nig) % gsz); pn = (wgid % nig) / gsz; }
        else { const int j = (i - 3 * nP) * P.G + P.c; if (j >= 2 * P.nN * 3 * SB) return false;
            const int tile = j / (3 * SB), rem = j - tile * 3 * SB; br = rem / SB; const int sl = rem - br * SB;
            pm = P.nM + tile / P.nN; pn = tile % P.nN; nt = P.ntf / SB; k0 = sl * nt * BK; ks = br * SB + sl; }
        u.pm = pm; u.pn = pn; u.k0 = k0; u.nt = nt; u.ks = ks; u.br = br; u.cont = cont; return true;
    }
    __device__ __forceinline__ void a_ready(const Unit&) const {}
    __device__ __forceinline__ void done(const Unit&) const {}
};
struct SliceOrder {
    int nN, ntiles, S, G, c, ntf;
    __host__ __device__ void init(int M, int N, int K, int S_, int G_, int c_) { nN = N / BM; ntiles = (M / BM) * nN; S = S_; G = G_; c = c_; ntf = K / BK; }
    __host__ __device__ __forceinline__ bool next(int i, Unit& u) const {
        const long j = (long)i * G + c; if (j >= (long)ntiles * S) return false;
        const int tile = (int)(j / S), ks = (int)(j - (long)tile * S), nt = ntf / S;
        u.pm = tile / nN; u.pn = tile % nN; u.k0 = ks * nt * BK; u.nt = nt; u.ks = ks; u.br = 0; u.cont = 0; return true;
    }
    __device__ __forceinline__ void a_ready(const Unit&) const {}
    __device__ __forceinline__ void done(const Unit&) const {}
};
__device__ __forceinline__ unsigned cvt_pk_bf16(float lo, float hi) { unsigned r; asm volatile("v_cvt_pk_bf16_f32 %0, %1, %2" : "=v"(r) : "v"(lo), "v"(hi)); return r; }
typedef unsigned u32x2 __attribute__((ext_vector_type(2)));
__device__ __forceinline__ float bf_lo(unsigned w) { return __uint_as_float(w << 16); }
__device__ __forceinline__ float bf_hi(unsigned w) { return __uint_as_float(w & 0xffff0000u); }
__device__ __forceinline__ float sigm(float x) { return __builtin_amdgcn_rcpf(1.0f + __expf(-x)); }

constexpr float NRM_INV_D = 1.0f / 2048.0f, NRM_EPS = 1e-6f;
__device__ __forceinline__ float rstd_of(float ss) { return __builtin_amdgcn_rsqf(ss * NRM_INV_D + NRM_EPS); }
typedef unsigned long long ssq_t;
constexpr float SSQ_SCALE = 16777216.0f, SSQ_INV = 1.0f / 16777216.0f;
__device__ __forceinline__ ssq_t ssq_of(float ss) { return (ssq_t)(ss * SSQ_SCALE); }
__device__ __forceinline__ float ss_load(const ssq_t* p) { return (float)__hip_atomic_load(p, __ATOMIC_RELAXED, __HIP_MEMORY_SCOPE_AGENT) * SSQ_INV; }
__device__ __forceinline__ float ssq_to_f(ssq_t v) { return (float)(unsigned)(v >> 32) * 256.0f + (float)(unsigned)v * SSQ_INV; }
__device__ __forceinline__ float ss_load_after_barrier(const ssq_t* p) { return ssq_to_f(*p); }
__device__ __forceinline__ void ss_store(ssq_t* p, float v) { __hip_atomic_store(p, ssq_of(v), __ATOMIC_RELAXED, __HIP_MEMORY_SCOPE_AGENT); }
__device__ __forceinline__ void ss_add(ssq_t* p, float v) { (void)__hip_atomic_fetch_add(p, ssq_of(v), __ATOMIC_RELAXED, __HIP_MEMORY_SCOPE_AGENT); }
template <int ACT> struct EpiBf16 {
    static constexpr bool PERM = true, AFTER_DRAIN = false;
    bf16_t* O; int ldc; const ssq_t* SS;
    __device__ __forceinline__ void operator()(const f32x4 (&acc)[2][2][4][2], const Unit& u, int wr, int wc, int fr, int fq) const {
        const int row0 = u.pm * BM + wr * 64 + fr, col0 = u.pn * BM + wc * 32 + 8 * fq;
        float rs[2][4];
        if (SS) { ssq_t q_[2][4];
#pragma unroll
            for (int ai = 0; ai < 2; ++ai)
#pragma unroll
                for (int m = 0; m < 4; ++m) q_[ai][m] = SS[row0 + ai * HALF + m * 16];
#pragma unroll
            for (int ai = 0; ai < 2; ++ai)
#pragma unroll
                for (int m = 0; m < 4; ++m) rs[ai][m] = rstd_of(ssq_to_f(q_[ai][m]));
        } else {
#pragma unroll
            for (int ai = 0; ai < 2; ++ai)
#pragma unroll
                for (int m = 0; m < 4; ++m) rs[ai][m] = 1.0f; }
#pragma unroll
        for (int ai = 0; ai < 2; ++ai)
#pragma unroll
            for (int m = 0; m < 4; ++m) { bf16_t* rowp = O + (size_t)(row0 + ai * HALF + m * 16) * ldc + col0;
#pragma unroll
                for (int bj = 0; bj < 2; ++bj) { f32x4 v0 = acc[ai][bj][m][0] * rs[ai][m], v1 = acc[ai][bj][m][1] * rs[ai][m];
                    if (ACT == 1) {
#pragma unroll
                        for (int j = 0; j < 4; ++j) { const float a = fmaxf(v0[j], 0.f), b = fmaxf(v1[j], 0.f); v0[j] = a * a; v1[j] = b * b; } }
                    u32x4 w; w.x = cvt_pk_bf16(v0[0], v0[1]); w.y = cvt_pk_bf16(v0[2], v0[3]); w.z = cvt_pk_bf16(v1[0], v1[1]); w.w = cvt_pk_bf16(v1[2], v1[3]);
                    *(u32x4*)(rowp + bj * HALF) = w; } }
    }
};
struct EpiZ {
    static constexpr bool PERM = true, AFTER_DRAIN = false;
    bf16_t* O; int ldc; const ssq_t* SS; unsigned char* G8; int ldg, gate_pn, glu_pn;
    __device__ __forceinline__ void operator()(const f32x4 (&acc)[2][2][4][2], const Unit& u, int wr, int wc, int fr, int fq) const {
        const int row0 = u.pm * BM + wr * 64 + fr, col0 = u.pn * BM + wc * 32 + 8 * fq;
        float rs[2][4]; ssq_t q_[2][4];
#pragma unroll
        for (int ai = 0; ai < 2; ++ai)
#pragma unroll
            for (int m = 0; m < 4; ++m) q_[ai][m] = SS[row0 + ai * HALF + m * 16];
#pragma unroll
        for (int ai = 0; ai < 2; ++ai)
#pragma unroll
            for (int m = 0; m < 4; ++m) rs[ai][m] = rstd_of(ssq_to_f(q_[ai][m]));
        if (u.pn < glu_pn) {
#pragma unroll
            for (int ai = 0; ai < 2; ++ai)
#pragma unroll
                for (int m = 0; m < 4; ++m) { bf16_t* rowp = O + (size_t)(row0 + ai * HALF + m * 16) * ldc + (col0 >> 1);
#pragma unroll
                    for (int bj = 0; bj < 2; ++bj) { const f32x4 x = acc[ai][bj][m][0] * rs[ai][m], g = acc[ai][bj][m][1] * rs[ai][m];
                        u32x2 w; w.x = cvt_pk_bf16(x[0] * sigm(g[0]), x[1] * sigm(g[1])); w.y = cvt_pk_bf16(x[2] * sigm(g[2]), x[3] * sigm(g[3]));
                        *(u32x2*)(rowp + bj * (HALF / 2)) = w; } }
        } else if (u.pn < gate_pn) { const int zc0 = col0 - glu_pn * (BM / 2);
#pragma unroll
            for (int ai = 0; ai < 2; ++ai)
#pragma unroll
                for (int m = 0; m < 4; ++m) { bf16_t* rowp = O + (size_t)(row0 + ai * HALF + m * 16) * ldc + zc0;
#pragma unroll
                    for (int bj = 0; bj < 2; ++bj) { const f32x4 v0 = acc[ai][bj][m][0] * rs[ai][m], v1 = acc[ai][bj][m][1] * rs[ai][m];
                        u32x4 w; w.x = cvt_pk_bf16(v0[0], v0[1]); w.y = cvt_pk_bf16(v0[2], v0[3]); w.z = cvt_pk_bf16(v1[0], v1[1]); w.w = cvt_pk_bf16(v1[2], v1[3]);
                        *(u32x4*)(rowp + bj * HALF) = w; } }
        } else { const int gc0 = col0 - gate_pn * BM;
#pragma unroll
            for (int ai = 0; ai < 2; ++ai)
#pragma unroll
                for (int m = 0; m < 4; ++m) { unsigned char* rowp = G8 + (size_t)(row0 + ai * HALF + m * 16) * ldg + gc0;
#pragma unroll
                    for (int bj = 0; bj < 2; ++bj) { u32x2 w; w.x = 0u; w.y = 0u;
                        const float rsl_ = rs[ai][m] * -1.4426950408889634f;
                        f32x4 e0 = acc[ai][bj][m][0] * rsl_, e1 = acc[ai][bj][m][1] * rsl_;
#pragma unroll
                        for (int j = 0; j < 4; ++j) { e0[j] = __builtin_amdgcn_exp2f(e0[j]); e1[j] = __builtin_amdgcn_exp2f(e1[j]); }
                        e0 = e0 + 1.0f; e1 = e1 + 1.0f;
#pragma unroll
                        for (int j = 0; j < 4; ++j) { e0[j] = __builtin_amdgcn_rcpf(e0[j]); e1[j] = __builtin_amdgcn_rcpf(e1[j]); }
                        e0 = e0 * 255.0f + 0.5f; e1 = e1 * 255.0f + 0.5f;
                        w.x = __builtin_amdgcn_cvt_pk_u8_f32(fmaxf(e0[0], 1.0f), 0, w.x); w.x = __builtin_amdgcn_cvt_pk_u8_f32(fmaxf(e0[1], 1.0f), 1, w.x);
                        w.x = __builtin_amdgcn_cvt_pk_u8_f32(fmaxf(e0[2], 1.0f), 2, w.x); w.x = __builtin_amdgcn_cvt_pk_u8_f32(fmaxf(e0[3], 1.0f), 3, w.x);
                        w.y = __builtin_amdgcn_cvt_pk_u8_f32(fmaxf(e1[0], 1.0f), 0, w.y); w.y = __builtin_amdgcn_cvt_pk_u8_f32(fmaxf(e1[1], 1.0f), 1, w.y);
                        w.y = __builtin_amdgcn_cvt_pk_u8_f32(fmaxf(e1[2], 1.0f), 2, w.y); w.y = __builtin_amdgcn_cvt_pk_u8_f32(fmaxf(e1[3], 1.0f), 3, w.y);
                        *(u32x2*)(rowp + bj * HALF) = w; } }
        }
    }
};
struct EpiResAdd {
    static constexpr bool PERM = false, AFTER_DRAIN = false;
    float* H; int ldc;
    __device__ __forceinline__ void operator()(const f32x4 (&acc)[2][2][4][2], const Unit& u, int wr, int wc, int fr, int fq) const {
        const int row0 = u.pm * BM + wr * 64 + fr, col0 = u.pn * BM + wc * 32 + 4 * fq;
#pragma unroll
        for (int ai = 0; ai < 2; ++ai)
#pragma unroll
            for (int m = 0; m < 4; ++m) { float* rowp = H + (size_t)(row0 + ai * HALF + m * 16) * ldc + col0;
#pragma unroll
                for (int bj = 0; bj < 2; ++bj)
#pragma unroll
                    for (int n = 0; n < 2; ++n) { float* p = rowp + bj * HALF + n * 16; const f32x4 b = *(const f32x4*)p; *(f32x4*)p = b + acc[ai][bj][m][n]; }
                if (m & 1) asm volatile("" ::: "memory"); }
    }
};
template <int MODE> struct EpiBranch {
    static constexpr bool PERM = false, AFTER_DRAIN = false;
    const bf16_t* Zg; int ldz; float* MG; bf16_t* OUT; int ldc;
    __device__ __forceinline__ void operator()(const f32x4 (&acc)[2][2][4][2], const Unit& u, int wr, int wc, int fr, int fq) const {
        const int row0 = u.pm * BM + wr * 64 + fr, col0 = u.pn * BM + wc * 32 + 4 * fq;
#pragma unroll
        for (int ai = 0; ai < 2; ++ai)
#pragma unroll
            for (int m = 0; m < 4; ++m) { const size_t r = (size_t)(row0 + ai * HALF + m * 16);
#pragma unroll
                for (int bj = 0; bj < 2; ++bj)
#pragma unroll
                    for (int n = 0; n < 2; ++n) { const int c = col0 + bj * HALF + n * 16;
                        const u32x2 gw = *(const u32x2*)(Zg + r * ldz + c);
                        f32x4 g; g[0] = sigm(bf_lo(gw.x)); g[1] = sigm(bf_hi(gw.x)); g[2] = sigm(bf_lo(gw.y)); g[3] = sigm(bf_hi(gw.y));
                        f32x4 v = g * acc[ai][bj][m][n];
                        float* mp = MG + r * ldc + c;
                        if (MODE == 0) { *(f32x4*)mp = v; }
                        else if (MODE == 1) { const f32x4 b = *(const f32x4*)mp; *(f32x4*)mp = b + v; }
                        else { const f32x4 b = *(const f32x4*)mp; v = b + v; u32x2 w; w.x = cvt_pk_bf16(v[0], v[1]); w.y = cvt_pk_bf16(v[2], v[3]); *(u32x2*)(OUT + r * ldc + c) = w; } }
                if (m & 1) asm volatile("" ::: "memory"); }
    }
};
struct EpiPle {
    static constexpr bool PERM = false, AFTER_DRAIN = false;
    float* H; const bf16_t* PP; int ldc;
    __device__ __forceinline__ void operator()(const f32x4 (&acc)[2][2][4][2], const Unit& u, int wr, int wc, int fr, int fq) const {
        const int row0 = u.pm * BM + wr * 64 + fr, col0 = u.pn * BM + wc * 32 + 4 * fq;
#pragma unroll
        for (int ai = 0; ai < 2; ++ai)
#pragma unroll
            for (int m = 0; m < 4; ++m) { const size_t r = (size_t)(row0 + ai * HALF + m * 16);
#pragma unroll
                for (int bj = 0; bj < 2; ++bj)
#pragma unroll
                    for (int n = 0; n < 2; ++n) { const int c = col0 + bj * HALF + n * 16;
                        const u32x2 pw = *(const u32x2*)(PP + r * ldc + c);
                        f32x4 pv; pv[0] = bf_lo(pw.x); pv[1] = bf_hi(pw.x); pv[2] = bf_lo(pw.y); pv[3] = bf_hi(pw.y);
                        const f32x4 a = acc[ai][bj][m][n]; f32x4 g; g[0] = sigm(a[0]); g[1] = sigm(a[1]); g[2] = sigm(a[2]); g[3] = sigm(a[3]);
                        float* p = H + r * ldc + c; const f32x4 b = *(const f32x4*)p; *(f32x4*)p = b + g * pv; }
                if (m & 1) asm volatile("" ::: "memory"); }
    }
};

template <int TAG> struct EpiResAddSplitT {
    static constexpr bool PERM = false, AFTER_DRAIN = false;
    float* H; int ldc; float* SLAB; int PMT; bf16_t* HB; ssq_t* SSo;
    __device__ __forceinline__ void operator()(const f32x4 (&acc)[2][2][4][2], const Unit& u, int wr, int wc, int fr, int fq) const {
        const int col0 = u.pn * BM + wc * 32 + 4 * fq;
        if (u.pm < PMT) { const int row0 = u.pm * BM + wr * 64 + fr;
#pragma unroll
            for (int ai = 0; ai < 2; ++ai)
#pragma unroll
                for (int m = 0; m < 4; ++m) { const size_t ro = (size_t)(row0 + ai * HALF + m * 16) * ldc + col0; float* rowp = H + ro; float ss = 0.f;
#pragma unroll
                    for (int bj = 0; bj < 2; ++bj)
#pragma unroll
                        for (int n = 0; n < 2; ++n) { float* p = rowp + bj * HALF + n * 16; const f32x4 b = *(const f32x4*)p; const f32x4 hn = b + acc[ai][bj][m][n]; *(f32x4*)p = hn;
                            u32x2 w; w.x = cvt_pk_bf16(hn[0], hn[1]); w.y = cvt_pk_bf16(hn[2], hn[3]); *(u32x2*)(HB + ro + bj * HALF + n * 16) = w;
                            ss += (hn[0] * hn[0] + hn[1] * hn[1]) + (hn[2] * hn[2] + hn[3] * hn[3]); }
                    { const int ln_ = fq * 16 + fr; ss += __builtin_bit_cast(float, __builtin_amdgcn_ds_bpermute((ln_ ^ 16) << 2, __builtin_bit_cast(int, ss))); ss += __builtin_bit_cast(float, __builtin_amdgcn_ds_bpermute((ln_ ^ 32) << 2, __builtin_bit_cast(int, ss))); }
                    if (fq == 0) ss_add(SSo + row0 + ai * HALF + m * 16, ss);
                    if (m & 1) asm volatile("" ::: "memory"); }
        } else { float* base = SLAB + ((size_t)u.ks * (2 * BM) + (size_t)(u.pm - PMT) * BM + wr * 64 + fr) * ldc + col0;
#pragma unroll
            for (int ai = 0; ai < 2; ++ai)
#pragma unroll
                for (int m = 0; m < 4; ++m) { float* rowp = base + (size_t)(ai * HALF + m * 16) * ldc;
#pragma unroll
                    for (int bj = 0; bj < 2; ++bj)
#pragma unroll
                        for (int n = 0; n < 2; ++n) *(f32x4*)(rowp + bj * HALF + n * 16) = acc[ai][bj][m][n]; }
        }
    }
};
typedef EpiResAddSplitT<0> EpiResAddSplit;
struct EpiPleSplit {
    static constexpr bool PERM = false, AFTER_DRAIN = false;
    float* H; const bf16_t* PP; int ldc; float* SLAB; int PMT; const ssq_t* SSi; bf16_t* HB; ssq_t* SSo;
    __device__ __forceinline__ void operator()(const f32x4 (&acc)[2][2][4][2], const Unit& u, int wr, int wc, int fr, int fq) const {
        const int col0 = u.pn * BM + wc * 32 + 4 * fq;
        if (u.pm < PMT) { const int row0 = u.pm * BM + wr * 64 + fr; ssq_t q_[2][4];
#pragma unroll
            for (int ai = 0; ai < 2; ++ai)
#pragma unroll
                for (int m = 0; m < 4; ++m) q_[ai][m] = SSi[row0 + ai * HALF + m * 16];
#pragma unroll
            for (int ai = 0; ai < 2; ++ai)
#pragma unroll
                for (int m = 0; m < 4; ++m) { const size_t r = (size_t)(row0 + ai * HALF + m * 16); const float rsi = rstd_of(ssq_to_f(q_[ai][m])); float ss = 0.f;
#pragma unroll
                    for (int bj = 0; bj < 2; ++bj)
#pragma unroll
                        for (int n = 0; n < 2; ++n) { const int c = col0 + bj * HALF + n * 16;
                            const u32x2 pw = *(const u32x2*)(PP + r * ldc + c);
                            f32x4 pv; pv[0] = bf_lo(pw.x); pv[1] = bf_hi(pw.x); pv[2] = bf_lo(pw.y); pv[3] = bf_hi(pw.y);
                            const f32x4 a = acc[ai][bj][m][n] * rsi; f32x4 g; g[0] = sigm(a[0]); g[1] = sigm(a[1]); g[2] = sigm(a[2]); g[3] = sigm(a[3]);
                            float* p = H + r * ldc + c; const f32x4 b = *(const f32x4*)p; const f32x4 hn = b + g * pv; *(f32x4*)p = hn;
                            u32x2 w; w.x = cvt_pk_bf16(hn[0], hn[1]); w.y = cvt_pk_bf16(hn[2], hn[3]); *(u32x2*)(HB + r * ldc + c) = w;
                            ss += (hn[0] * hn[0] + hn[1] * hn[1]) + (hn[2] * hn[2] + hn[3] * hn[3]); }
                    { const int ln_ = fq * 16 + fr; ss += __builtin_bit_cast(float, __builtin_amdgcn_ds_bpermute((ln_ ^ 16) << 2, __builtin_bit_cast(int, ss))); ss += __builtin_bit_cast(float, __builtin_amdgcn_ds_bpermute((ln_ ^ 32) << 2, __builtin_bit_cast(int, ss))); }
                    if (fq == 0) ss_add(SSo + r, ss);
                    if (m & 1) asm volatile("" ::: "memory"); }
        } else { float* base = SLAB + ((size_t)u.ks * (2 * BM) + (size_t)(u.pm - PMT) * BM + wr * 64 + fr) * ldc + col0;
#pragma unroll
            for (int ai = 0; ai < 2; ++ai)
#pragma unroll
                for (int m = 0; m < 4; ++m) { float* rowp = base + (size_t)(ai * HALF + m * 16) * ldc;
#pragma unroll
                    for (int bj = 0; bj < 2; ++bj)
#pragma unroll
                        for (int n = 0; n < 2; ++n) *(f32x4*)(rowp + bj * HALF + n * 16) = acc[ai][bj][m][n]; }
        }
    }
};

struct EpiBranchFused {
    static constexpr bool PERM = true, AFTER_DRAIN = false;
    const unsigned char* G8; int ldg; bf16_t* OUT; int ldc; bf16_t* SLAB; int PMT;
    static __device__ __forceinline__ void gates8w(const u32x2 w, float (&g)[8]) {

        g[0] = (float)(w.x & 0xffu); g[1] = (float)((w.x >> 8) & 0xffu); g[2] = (float)((w.x >> 16) & 0xffu); g[3] = (float)(w.x >> 24);
        g[4] = (float)(w.y & 0xffu); g[5] = (float)((w.y >> 8) & 0xffu); g[6] = (float)((w.y >> 16) & 0xffu); g[7] = (float)(w.y >> 24);
    }
    __device__ __forceinline__ void operator()(f32x4 (&acc)[2][2][4][2], const Unit& u, int wr, int wc, int fr, int fq) const {
        const int row0 = u.pm * BM + wr * 64 + fr, col0 = u.pn * BM + wc * 32 + 8 * fq;
        const bool prompt = u.pm < PMT; const bool ratio = prompt && u.br < 2;
        u32x2 gaq[2][4][2], gbq[2][4][2];
        if (ratio) {
#pragma unroll
        for (int ai = 0; ai < 2; ++ai)
#pragma unroll
            for (int m = 0; m < 4; ++m)
#pragma unroll
                for (int bj = 0; bj < 2; ++bj) { const unsigned char* gp = G8 + (size_t)(row0 + ai * HALF + m * 16) * ldg + (size_t)u.br * 2048 + col0 + bj * HALF;
                    gaq[ai][m][bj] = *(const u32x2*)gp; gbq[ai][m][bj] = *(const u32x2*)(gp + 2048); }
        } else {
#pragma unroll
        for (int ai = 0; ai < 2; ++ai)
#pragma unroll
            for (int m = 0; m < 4; ++m)
#pragma unroll
                for (int bj = 0; bj < 2; ++bj) { const unsigned char* gp = G8 + (size_t)(row0 + ai * HALF + m * 16) * ldg + (size_t)u.br * 2048 + col0 + bj * HALF;
                    gaq[ai][m][bj] = *(const u32x2*)gp; gbq[ai][m][bj] = (u32x2){0x01010101u, 0x01010101u}; }
        }
#pragma unroll
        for (int ai = 0; ai < 2; ++ai) {
#pragma unroll
            for (int m = 0; m < 4; ++m) { const size_t r = (size_t)(row0 + ai * HALF + m * 16);
#pragma unroll
                for (int bj = 0; bj < 2; ++bj) { const int c = col0 + bj * HALF;
                    float ga[8]; gates8w(gaq[ai][m][bj], ga); f32x4& v0 = acc[ai][bj][m][0]; f32x4& v1 = acc[ai][bj][m][1];
                    if (ratio) { float gb[8]; gates8w(gbq[ai][m][bj], gb);
                        { f32x4 r0_, r1_;
#pragma unroll
                          for (int j = 0; j < 4; ++j) { r0_[j] = __builtin_amdgcn_rcpf(gb[j]); r1_[j] = __builtin_amdgcn_rcpf(gb[4 + j]); }
                          v0 = v0 * (r0_ * (f32x4){ga[0], ga[1], ga[2], ga[3]}); v1 = v1 * (r1_ * (f32x4){ga[4], ga[5], ga[6], ga[7]}); }
                    } else { f32x4 o0, o1;
#pragma unroll
                        for (int j = 0; j < 4; ++j) { o0[j] = v0[j] * (ga[j] * (1.0f / 255.0f)); o1[j] = v1[j] * (ga[4 + j] * (1.0f / 255.0f)); }
                        if (prompt) { u32x4 w; w.x = cvt_pk_bf16(o0[0], o0[1]); w.y = cvt_pk_bf16(o0[2], o0[3]); w.z = cvt_pk_bf16(o1[0], o1[1]); w.w = cvt_pk_bf16(o1[2], o1[3]); *(u32x4*)(OUT + r * ldc + c) = w; }
                        else { bf16_t* sp = SLAB + ((size_t)u.ks * (2 * BM) + (r - (size_t)PMT * BM)) * ldc + c; u32x4 w; w.x = cvt_pk_bf16(o0[0], o0[1]); w.y = cvt_pk_bf16(o0[2], o0[3]); w.z = cvt_pk_bf16(o1[0], o1[1]); w.w = cvt_pk_bf16(o1[2], o1[3]); *(u32x4*)sp = w; } } }
                if (m & 1) asm volatile("" ::: "memory"); } }
    }
};

struct EpiResBf16Split {
    static constexpr bool PERM = true, AFTER_DRAIN = false;
    const bf16_t* Hin; bf16_t* Hout; int ldc; bf16_t* SLAB; int PMT; ssq_t* SSo;
    __device__ __forceinline__ void operator()(const f32x4 (&acc)[2][2][4][2], const Unit& u, int wr, int wc, int fr, int fq) const {
        const int col0 = u.pn * BM + wc * 32 + 8 * fq;
        if (u.pm < PMT) { const int row0 = u.pm * BM + wr * 64 + fr;
            u32x4 hq[2][4][2];
#pragma unroll
            for (int ai = 0; ai < 2; ++ai)
#pragma unroll
                for (int m = 0; m < 4; ++m)
#pragma unroll
                    for (int bj = 0; bj < 2; ++bj) hq[ai][m][bj] = *(const u32x4*)(Hin + (size_t)(row0 + ai * HALF + m * 16) * ldc + col0 + bj * HALF);
#pragma unroll
            for (int ai = 0; ai < 2; ++ai) {
#pragma unroll
                for (int m = 0; m < 4; ++m) { const size_t ro = (size_t)(row0 + ai * HALF + m * 16) * ldc + col0; float ss = 0.f;
#pragma unroll
                    for (int bj = 0; bj < 2; ++bj) { const u32x4 hw = hq[ai][m][bj];
                        const f32x4 h0 = (f32x4){bf_lo(hw.x), bf_hi(hw.x), bf_lo(hw.y), bf_hi(hw.y)}, h1 = (f32x4){bf_lo(hw.z), bf_hi(hw.z), bf_lo(hw.w), bf_hi(hw.w)};
                        const f32x4 v0 = h0 + acc[ai][bj][m][0], v1 = h1 + acc[ai][bj][m][1];
                        u32x4 w; w.x = cvt_pk_bf16(v0[0], v0[1]); w.y = cvt_pk_bf16(v0[2], v0[3]); w.z = cvt_pk_bf16(v1[0], v1[1]); w.w = cvt_pk_bf16(v1[2], v1[3]);
                        *(u32x4*)(Hout + ro + bj * HALF) = w;
                        ss += ((v0[0] * v0[0] + v0[1] * v0[1]) + (v0[2] * v0[2] + v0[3] * v0[3])) + ((v1[0] * v1[0] + v1[1] * v1[1]) + (v1[2] * v1[2] + v1[3] * v1[3])); }
                    { const int ln_ = fq * 16 + fr; ss += __builtin_bit_cast(float, __builtin_amdgcn_ds_bpermute((ln_ ^ 16) << 2, __builtin_bit_cast(int, ss))); ss += __builtin_bit_cast(float, __builtin_amdgcn_ds_bpermute((ln_ ^ 32) << 2, __builtin_bit_cast(int, ss))); }
                    if (fq == 0) ss_add(SSo + row0 + ai * HALF + m * 16, ss);
                    if (m & 1) asm volatile("" ::: "memory"); } }
        } else { bf16_t* base = SLAB + ((size_t)u.ks * (2 * BM) + (size_t)(u.pm - PMT) * BM + wr * 64 + fr) * ldc + col0;
#pragma unroll
            for (int ai = 0; ai < 2; ++ai)
#pragma unroll
                for (int m = 0; m < 4; ++m) { bf16_t* rowp = base + (size_t)(ai * HALF + m * 16) * ldc;
#pragma unroll
                    for (int bj = 0; bj < 2; ++bj) { const f32x4 a0 = acc[ai][bj][m][0], a1 = acc[ai][bj][m][1]; u32x4 w; w.x = cvt_pk_bf16(a0[0], a0[1]); w.y = cvt_pk_bf16(a0[2], a0[3]); w.z = cvt_pk_bf16(a1[0], a1[1]); w.w = cvt_pk_bf16(a1[2], a1[3]); *(u32x4*)(rowp + bj * HALF) = w; } }
        }
    }
};
struct EpiPleBf16Split {
    static constexpr bool PERM = true, AFTER_DRAIN = false;
    const bf16_t* Hin; bf16_t* Hout; const bf16_t* PP; int ldc; bf16_t* SLAB; int PMT; const ssq_t* SSi; ssq_t* SSo;
    __device__ __forceinline__ void operator()(const f32x4 (&acc)[2][2][4][2], const Unit& u, int wr, int wc, int fr, int fq) const {
        const int col0 = u.pn * BM + wc * 32 + 8 * fq;
        if (u.pm < PMT) { const int row0 = u.pm * BM + wr * 64 + fr; ssq_t q_[2][4];
#pragma unroll
            for (int ai = 0; ai < 2; ++ai)
#pragma unroll
                for (int m = 0; m < 4; ++m) q_[ai][m] = SSi[row0 + ai * HALF + m * 16];
#pragma unroll
            for (int ai = 0; ai < 2; ++ai) {
                u32x4 hq[4][2], pq[4][2];
#pragma unroll
                for (int m = 0; m < 4; ++m) {
                  if ((m & 1) == 0) {
#pragma unroll
                    for (int mm = m; mm < m + 2; ++mm)
#pragma unroll
                      for (int bj = 0; bj < 2; ++bj) { const size_t ro2 = (size_t)(row0 + ai * HALF + mm * 16) * ldc + col0 + bj * HALF; hq[mm][bj] = *(const u32x4*)(Hin + ro2); pq[mm][bj] = *(const u32x4*)(PP + ro2); } }
                  const size_t ro = (size_t)(row0 + ai * HALF + m * 16) * ldc + col0; const float rsi = rstd_of(ssq_to_f(q_[ai][m])); float ss = 0.f;
#pragma unroll
                    for (int bj = 0; bj < 2; ++bj) { const u32x4 hw = hq[m][bj], pw = pq[m][bj];
                        const float h[8] = {bf_lo(hw.x), bf_hi(hw.x), bf_lo(hw.y), bf_hi(hw.y), bf_lo(hw.z), bf_hi(hw.z), bf_lo(hw.w), bf_hi(hw.w)};
                        const float p[8] = {bf_lo(pw.x), bf_hi(pw.x), bf_lo(pw.y), bf_hi(pw.y), bf_lo(pw.z), bf_hi(pw.z), bf_lo(pw.w), bf_hi(pw.w)};
                        float v[8];
                        { const float rsl_ = rsi * -1.4426950408889634f;
                          f32x4 e0 = acc[ai][bj][m][0] * rsl_, e1 = acc[ai][bj][m][1] * rsl_;
#pragma unroll
                          for (int j = 0; j < 4; ++j) { e0[j] = __builtin_amdgcn_exp2f(e0[j]); e1[j] = __builtin_amdgcn_exp2f(e1[j]); }
                          e0 = e0 + 1.0f; e1 = e1 + 1.0f;
#pragma unroll
                          for (int j = 0; j < 4; ++j) { e0[j] = __builtin_amdgcn_rcpf(e0[j]); e1[j] = __builtin_amdgcn_rcpf(e1[j]); }
                          const f32x4 h0 = (f32x4){h[0], h[1], h[2], h[3]}, h1 = (f32x4){h[4], h[5], h[6], h[7]}, p0 = (f32x4){p[0], p[1], p[2], p[3]}, p1 = (f32x4){p[4], p[5], p[6], p[7]};
                          const f32x4 r0 = e0 * p0 + h0, r1 = e1 * p1 + h1;
#pragma unroll
                          for (int j = 0; j < 4; ++j) { v[j] = r0[j]; v[4 + j] = r1[j]; } }
                        u32x4 w; w.x = cvt_pk_bf16(v[0], v[1]); w.y = cvt_pk_bf16(v[2], v[3]); w.z = cvt_pk_bf16(v[4], v[5]); w.w = cvt_pk_bf16(v[6], v[7]);
                        *(u32x4*)(Hout + ro + bj * HALF) = w;
#pragma unroll
                        for (int j = 0; j < 8; ++j) ss += v[j] * v[j]; }
                    { const int ln_ = fq * 16 + fr; ss += __builtin_bit_cast(float, __builtin_amdgcn_ds_bpermute((ln_ ^ 16) << 2, __builtin_bit_cast(int, ss))); ss += __builtin_bit_cast(float, __builtin_amdgcn_ds_bpermute((ln_ ^ 32) << 2, __builtin_bit_cast(int, ss))); }
                    if (fq == 0) ss_add(SSo + row0 + ai * HALF + m * 16, ss);
                    if (m & 1) asm volatile("" ::: "memory"); } }
        } else { bf16_t* base = SLAB + ((size_t)u.ks * (2 * BM) + (size_t)(u.pm - PMT) * BM + wr * 64 + fr) * ldc + col0;
#pragma unroll
            for (int ai = 0; ai < 2; ++ai)
#pragma unroll
                for (int m = 0; m < 4; ++m) { bf16_t* rowp = base + (size_t)(ai * HALF + m * 16) * ldc;
#pragma unroll
                    for (int bj = 0; bj < 2; ++bj) { const f32x4 a0 = acc[ai][bj][m][0], a1 = acc[ai][bj][m][1]; u32x4 w; w.x = cvt_pk_bf16(a0[0], a0[1]); w.y = cvt_pk_bf16(a0[2], a0[3]); w.z = cvt_pk_bf16(a1[0], a1[1]); w.w = cvt_pk_bf16(a1[2], a1[3]); *(u32x4*)(rowp + bj * HALF) = w; } }
        }
    }
};

struct EpiSlabBf16 {
    static constexpr bool PERM = true, AFTER_DRAIN = false;
    bf16_t* SLAB; int ldc, mrows;
    __device__ __forceinline__ void operator()(const f32x4 (&acc)[2][2][4][2], const Unit& u, int wr, int wc, int fr, int fq) const {
        bf16_t* base = SLAB + ((size_t)u.ks * mrows + (size_t)u.pm * BM + wr * 64 + fr) * ldc + u.pn * BM + wc * 32 + 8 * fq;
#pragma unroll
        for (int ai = 0; ai < 2; ++ai)
#pragma unroll
            for (int m = 0; m < 4; ++m) { bf16_t* rowp = base + (size_t)(ai * HALF + m * 16) * ldc;
#pragma unroll
                for (int bj = 0; bj < 2; ++bj) { const f32x4 a0 = acc[ai][bj][m][0], a1 = acc[ai][bj][m][1]; u32x4 w; w.x = cvt_pk_bf16(a0[0], a0[1]); w.y = cvt_pk_bf16(a0[2], a0[3]); w.z = cvt_pk_bf16(a1[0], a1[1]); w.w = cvt_pk_bf16(a1[2], a1[3]); *(u32x4*)(rowp + bj * HALF) = w; } }
    }
};

template <class Epi, class Sched, bool ALIGN_EPI = false, bool SP2 = false>
__device__ __forceinline__ void gemm_phase(PG8_LAS unsigned char* lds, const Gemm g, const Sched& S, const Epi& E) {
    int tid_ = threadIdx.x; asm volatile("" : "+v"(tid_));
    const int tid = tid_, wid = __builtin_amdgcn_readfirstlane(tid >> 6), lane = tid & 63, wr = wid >> 2, wc = wid & 3, fr = lane & 15, fq = lane >> 4;
    const int lda = g.lda ? g.lda : g.K, ldb = g.ldb ? g.ldb : g.K;
    unsigned voffA[2], voffB[2];
#pragma unroll
    for (int i = 0; i < 2; ++i) { int R, C; stage_rc(tid * 16 + i * 8192, R, C); const int Rb = Epi::PERM ? ((R & ~31) + perm32(R & 31)) : R;
        voffA[i] = (unsigned)(R * lda + C) * 2u; voffB[i] = (unsigned)(Rb * ldb + C) * 2u; }
    const size_t kstep = (size_t)(BK * 2);
    const size_t hstepA = (size_t)HALF * lda * 2, hstepB = (size_t)HALF * ldb * 2;
    const size_t tstepA = 2 * hstepA, tstepB = 2 * hstepB;
    const unsigned ldsw = (unsigned)wid * 1024u;
    const int aoff = lds_byte(wr * 64 + fr, fq * 8), boff = lds_byte(wc * 32 + fr, fq * 8);
#define PG8_SA(b, h) (((b) * 2 + (h)) * HTB)
#define PG8_SB(b, h) ((4 + (b) * 2 + (h)) * HTB)
#define PG8_STAGE(bufoff, gbase, voff) do { _Pragma("unroll") for (int _i = 0; _i < 2; ++_i) \
        __builtin_amdgcn_global_load_lds((const unsigned*)((const char*)(gbase) + (voff)[_i]), (PG8_LAS unsigned*)(lds + (bufoff) + ldsw + _i * 8192), 16, 0, 0); } while (0)
#define PG8_LDA(dst, b, h) do { _Pragma("unroll") for (int m = 0; m < 4; ++m) _Pragma("unroll") for (int k = 0; k < 2; ++k) dst[m][k] = *(const PG8_LAS bf16x8*)(lds + PG8_SA(b, h) + aoff + m * 2048 + k * 1024); } while (0)
#define PG8_LDB(dst, b, h) do { _Pragma("unroll") for (int n = 0; n < 2; ++n) _Pragma("unroll") for (int k = 0; k < 2; ++k) dst[n][k] = *(const PG8_LAS bf16x8*)(lds + PG8_SB(b, h) + boff + n * 2048 + k * 1024); } while (0)
#define PG8_MMA(ai, bj, At, Bt) do { __builtin_amdgcn_s_setprio(1); _Pragma("unroll") for (int m = 0; m < 4; ++m) _Pragma("unroll") for (int n = 0; n < 2; ++n) _Pragma("unroll") for (int k = 0; k < 2; ++k) \
        acc[ai][bj][m][n] = __builtin_amdgcn_mfma_f32_16x16x32_bf16(Bt[n][k], At[m][k], acc[ai][bj][m][n], 0, 0, 0); __builtin_amdgcn_s_setprio(0); } while (0)
#define PG8_WAIT_V(n) asm volatile("s_waitcnt vmcnt(" #n ")" ::: "memory")
#define PG8_WAIT_L(n) asm volatile("s_waitcnt lgkmcnt(" #n ")" ::: "memory")
#define PG8_BAR __builtin_amdgcn_s_barrier()
#define PG8_SCHED __builtin_amdgcn_sched_barrier(0)
    Unit cur, nxt; int ui = 0;
    if (!S.next(0, cur)) return;
    f32x4 acc[2][2][4][2];
#pragma unroll
    for (int a = 0; a < 2; ++a)
#pragma unroll
        for (int b = 0; b < 2; ++b)
#pragma unroll
            for (int m = 0; m < 4; ++m)
#pragma unroll
                for (int n = 0; n < 2; ++n) acc[a][b][m][n] = (f32x4){0.f, 0.f, 0.f, 0.f};
    bf16x8 At[4][2], B0[2][2], B1[2][2];
    const char* cA = (const char*)g.A + (size_t)cur.br * g.abr + (size_t)cur.pm * tstepA + (size_t)cur.k0 * 2; const char* cB = (const char*)g.Bt + (size_t)cur.br * g.bbr + (size_t)cur.pn * tstepB + (size_t)cur.k0 * 2;
    S.a_ready(cur);
    if constexpr (SP2) {
        PG8_STAGE(PG8_SB(0, 0), cB, voffB); PG8_STAGE(PG8_SB(0, 1), cB + hstepB, voffB); PG8_STAGE(PG8_SA(0, 0), cA, voffA); PG8_STAGE(PG8_SA(0, 1), cA + hstepA, voffA);
        if (wr == 1) PG8_BAR;
        PG8_WAIT_V(2); PG8_BAR;
        PG8_STAGE(PG8_SB(1, 0), cB + kstep, voffB); PG8_STAGE(PG8_SA(1, 0), cA + kstep, voffA); PG8_STAGE(PG8_SB(1, 1), cB + hstepB + kstep, voffB);
        PG8_WAIT_V(6); PG8_BAR;
    } else {
        PG8_STAGE(PG8_SB(0, 0), cB, voffB); PG8_STAGE(PG8_SA(0, 0), cA, voffA); PG8_STAGE(PG8_SB(0, 1), cB + hstepB, voffB); PG8_STAGE(PG8_SA(0, 1), cA + hstepA, voffA);
        if (wr == 1) PG8_BAR;
        PG8_WAIT_V(4); PG8_BAR;
        PG8_STAGE(PG8_SB(1, 0), cB + kstep, voffB); PG8_STAGE(PG8_SA(1, 0), cA + kstep, voffA); PG8_STAGE(PG8_SB(1, 1), cB + hstepB + kstep, voffB);
        PG8_WAIT_V(6); PG8_BAR;
    }
    for (;;) {
        const bool has_next = S.next(ui + 1, nxt);
        const char* nA = has_next ? (const char*)g.A + (size_t)nxt.br * g.abr + (size_t)nxt.pm * tstepA + (size_t)nxt.k0 * 2 : cA; const char* nB = has_next ? (const char*)g.Bt + (size_t)nxt.br * g.bbr + (size_t)nxt.pn * tstepB + (size_t)nxt.k0 * 2 : cB;
        const int nt = cur.nt;
        for (int t = 0; t < nt; t += 2) {
            const bool last = (t == nt - 2);
            const char* a1 = cA + (size_t)(t + 1) * kstep;
            const char* a2 = last ? nA : cA + (size_t)(t + 2) * kstep; const char* b2 = last ? nB : cB + (size_t)(t + 2) * kstep;
            const char* a3 = a2 + kstep; const char* b3 = b2 + kstep;
            if (last && has_next) S.a_ready(nxt);
            if constexpr (SP2) {
            PG8_LDB(B0, 0, 0); PG8_LDB(B1, 0, 1); PG8_SCHED; PG8_LDA(At, 0, 0); PG8_STAGE(PG8_SA(1, 1), a1 + hstepA, voffA);
            PG8_WAIT_V(8); PG8_WAIT_L(0); PG8_BAR; PG8_MMA(0, 0, At, B0); PG8_MMA(0, 1, At, B1); PG8_BAR; PG8_SCHED;
            PG8_LDA(At, 0, 1); PG8_STAGE(PG8_SB(0, 0), b2, voffB); PG8_STAGE(PG8_SB(0, 1), b2 + hstepB, voffB); PG8_STAGE(PG8_SA(0, 0), a2, voffA);
            PG8_WAIT_V(8); PG8_WAIT_L(0); PG8_BAR; PG8_MMA(1, 0, At, B0); PG8_MMA(1, 1, At, B1); PG8_BAR; PG8_SCHED;
            PG8_LDB(B0, 1, 0); PG8_LDB(B1, 1, 1); PG8_SCHED; PG8_LDA(At, 1, 0); PG8_STAGE(PG8_SA(0, 1), a2 + hstepA, voffA);
            PG8_WAIT_V(8); PG8_WAIT_L(0); PG8_BAR; PG8_MMA(0, 0, At, B0); PG8_MMA(0, 1, At, B1); PG8_BAR; PG8_SCHED;
            PG8_LDA(At, 1, 1); PG8_STAGE(PG8_SB(1, 0), b3, voffB); PG8_STAGE(PG8_SB(1, 1), b3 + hstepB, voffB); PG8_STAGE(PG8_SA(1, 0), a3, voffA);
            PG8_WAIT_V(8); PG8_WAIT_L(0); PG8_BAR; PG8_MMA(1, 0, At, B0); PG8_MMA(1, 1, At, B1); PG8_BAR; PG8_SCHED;
            } else {
            PG8_LDB(B0, 0, 0); PG8_SCHED; PG8_LDA(At, 0, 0); PG8_STAGE(PG8_SA(1, 1), a1 + hstepA, voffA);
            PG8_WAIT_L(8); PG8_BAR; PG8_WAIT_L(0); PG8_MMA(0, 0, At, B0); PG8_BAR; PG8_SCHED;
            PG8_LDB(B1, 0, 1); PG8_STAGE(PG8_SB(0, 0), b2, voffB);
            PG8_BAR; PG8_WAIT_L(0); PG8_MMA(0, 1, At, B1); PG8_BAR;
            PG8_LDA(At, 0, 1); PG8_STAGE(PG8_SA(0, 0), a2, voffA);
            PG8_BAR; PG8_WAIT_L(0); PG8_MMA(1, 0, At, B0); PG8_BAR; PG8_SCHED;
            PG8_STAGE(PG8_SB(0, 1), b2 + hstepB, voffB);
            PG8_WAIT_V(6); PG8_BAR; PG8_MMA(1, 1, At, B1); PG8_BAR;
            PG8_LDB(B0, 1, 0); PG8_SCHED; PG8_LDA(At, 1, 0); PG8_STAGE(PG8_SA(0, 1), a2 + hstepA, voffA);
            PG8_WAIT_L(8); PG8_BAR; PG8_WAIT_L(0); PG8_MMA(0, 0, At, B0); PG8_BAR; PG8_SCHED;
            PG8_LDB(B1, 1, 1); PG8_STAGE(PG8_SB(1, 0), b3, voffB);
            PG8_BAR; PG8_WAIT_L(0); PG8_MMA(0, 1, At, B1); PG8_BAR;
            PG8_LDA(At, 1, 1); PG8_STAGE(PG8_SA(1, 0), a3, voffA);
            PG8_BAR; PG8_WAIT_L(0); PG8_MMA(1, 0, At, B0); PG8_BAR; PG8_SCHED;
            PG8_STAGE(PG8_SB(1, 1), b3 + hstepB, voffB);
            PG8_WAIT_V(6); PG8_BAR; PG8_MMA(1, 1, At, B1); PG8_BAR;
            }
        }
        if constexpr (ALIGN_EPI) { if (wr == 0) PG8_BAR; }
        if constexpr (!Epi::AFTER_DRAIN) { E(acc, cur, wr, wc, fr, fq);
#if defined(PROBE_EPI2)
            if constexpr (Epi::PERM) { if (cur.cont == 0 && cur.br == 0) E(acc, cur, wr, wc, fr, fq); }
#endif
            S.done(cur); }
        if (!has_next) break;
        if (!cur.cont) {
#pragma unroll
        for (int a = 0; a < 2; ++a)
#pragma unroll
            for (int b = 0; b < 2; ++b)
#pragma unroll
                for (int m = 0; m < 4; ++m)
#pragma unroll
                    for (int n = 0; n < 2; ++n) acc[a][b][m][n] = (f32x4){0.f, 0.f, 0.f, 0.f};
        }
        cur = nxt; cA = nA; cB = nB; ++ui;
        if constexpr (ALIGN_EPI) { if (wr == 1) PG8_BAR; }
    }
    PG8_WAIT_V(0);
    if constexpr (!ALIGN_EPI) { if (wr == 0) PG8_BAR; }
    PG8_BAR;
    if constexpr (Epi::AFTER_DRAIN) { E.fused(acc, cur, wr, wc, fr, fq, lds, wid, lane); S.done(cur); }
#undef PG8_SA
#undef PG8_SB
#undef PG8_STAGE
#undef PG8_LDA
#undef PG8_LDB
#undef PG8_MMA
#undef PG8_WAIT_V
#undef PG8_WAIT_L
#undef PG8_BAR
#undef PG8_SCHED
}
}
#ifndef PG8_SP2
#define PG8_SP2 true
#endif
#ifndef PG8_ALIGN
#define PG8_ALIGN true
#endif
#ifndef MK_PER_PHASE
#define MK_PER_PHASE 0
#endif

constexpr int NWAVES = 8;
constexpr int DM = 2048, DEPTH = 4, MP = 8192, MS = 512, MTOK = MP + MS;
constexpr int SEQ = 4096, DSEQ = 32, DBATCH = 16, PBATCH = 2;
constexpr int CONVD = 1024, CONVW = 31, GMD = 1024, NHEAD = 8, HDIM = 128, ATD = 1024, DFF = 8192, PLED = 256;
constexpr int INC = 13312, ZG = 7168;
constexpr int ZA = 0, ZB = 1024, ZQ = 3072, ZK = 4096, ZV = 5120;
constexpr int ZP = 6144;
constexpr int WCACHE = 512;
constexpr float EPS = 1e-6f;
constexpr size_t O_YP = 0, O_YS = 16777216, O_CSP = 17825792, O_CSS = 18071552, O_KP = 20037632, O_VP = 24231936, O_KS = 28426240, O_VS = 30523392, O_GV = 32620544, O_END = 34717696;
constexpr size_t MiB = 1u << 20;
constexpr size_t WS_CTL = 0, CTL_ZERO_BYTES = 1 * MiB;
constexpr int LD_T = DFF + 64;
constexpr int LD2 = DM, LD1 = CONVD;
constexpr size_t WS_WT = 1 * MiB, WT_LAYER = 154 * MiB;
constexpr size_t WT_IN = 0, WT_A = 54 * MiB, WT_B = 59 * MiB, WT_C = 64 * MiB, WT_O = 69 * MiB, WT_F1 = 78 * MiB, WT_F2 = 111 * MiB, WT_PG = 144 * MiB, WT_PP = 153 * MiB;
constexpr size_t WS_H = 617 * MiB, WS_XN = 685 * MiB, WS_Z = 721 * MiB, WS_YA = 942 * MiB, WS_YB = 961 * MiB, WS_O = 980 * MiB, WS_V = 999 * MiB, WS_MG = 1016 * MiB, WS_MERGED = 1084 * MiB, WS_PLE = 1120 * MiB, WS_SLAB = 1137 * MiB, WS_SS = 1201 * MiB, WS_PP4 = 1202 * MiB, WS_G8 = 1338 * MiB, WS_END = 1390 * MiB;
constexpr size_t WS_T = WS_Z;
static_assert(WS_WT + 4 * WT_LAYER == WS_H && WS_Z + (size_t)MTOK * ZP * 2 <= WS_YA && WS_T + (size_t)MTOK * LD_T * 2 <= WS_YA && WT_F2 + (size_t)DM * LD_T * 2 <= WT_PG && WT_IN + (size_t)INC * LD2 * 2 <= WT_A && WT_F1 + (size_t)DFF * LD2 * 2 <= WT_F2 && WT_O + (size_t)DM * LD2 * 2 <= WT_F1 && WT_PG + (size_t)DM * LD2 * 2 <= WT_PP && WS_XN + (size_t)MTOK * LD2 * 2 <= WS_Z && WS_MERGED + (size_t)MTOK * LD2 * 2 <= WS_PLE && WS_YA + (size_t)MTOK * LD1 * 2 <= WS_YB && WS_O + (size_t)MTOK * LD1 * 2 <= WS_V, "ws map");
constexpr int CW_BAR = 4096;

constexpr int RING_OFF = 0, RING_BYTES = 131072;
constexpr int LDSCTL_OFF = RING_BYTES, MISC_OFF = LDSCTL_OFF + 320;
constexpr int LDS_BYTES = 147456;

#define GAS __attribute__((address_space(1)))
#define LAS __attribute__((address_space(3)))
typedef unsigned short bf16;
typedef unsigned v4u __attribute__((ext_vector_type(4)));
typedef float f32x4 __attribute__((ext_vector_type(4)));
typedef short bf16x8 __attribute__((ext_vector_type(8)));
typedef GAS unsigned gu32;
typedef GAS unsigned long long gu64;
#define RLX_AGENT __ATOMIC_RELAXED, __HIP_MEMORY_SCOPE_AGENT
#define LDS_WAIT() asm volatile("s_waitcnt lgkmcnt(0)" ::: "memory")
#define VM_WAIT() asm volatile("s_waitcnt vmcnt(0)" ::: "memory")
__device__ __forceinline__ unsigned long long rt() { return __builtin_amdgcn_s_memrealtime(); }
__device__ __forceinline__ unsigned f2bf(float f) { unsigned u = __builtin_bit_cast(unsigned, f); return (u + 0x7fffu + ((u >> 16) & 1u)) >> 16; }
__device__ __forceinline__ unsigned pk2(float lo, float hi) { return f2bf(lo) | (f2bf(hi) << 16); }

#define XB_TMO      128
#define XB_XCNT(j)  (256  + 64 * (j))
#define XB_XSUB(j)  (1280 + 64 * (j))
#define XB_XGEN(j)  (2304 + 64 * (j))
#define XB_TOP      3328
#define XB_TOPGEN   3392
#define XCD_BAR_WORDS 3456
#define XB_SPIN_CAP (1u << 18)

__device__ __forceinline__ unsigned xb_ld(unsigned* p)              { return __hip_atomic_load(p, __ATOMIC_RELAXED, __HIP_MEMORY_SCOPE_AGENT); }
__device__ __forceinline__ unsigned xb_add(unsigned* p, unsigned v) { return __hip_atomic_fetch_add(p, v, __ATOMIC_RELAXED, __HIP_MEMORY_SCOPE_AGENT); }
__device__ __forceinline__ unsigned xb_xcc_id() { return (unsigned)__builtin_amdgcn_s_getreg((3 << 11) | 20) & 0xFu; }
#define XB_SPIN(cond, bar) do { unsigned _sp = 0; while (cond) { __builtin_amdgcn_s_sleep(1); \
    if ((++_sp & 255u) == 0u) { if (xb_ld(&(bar)[XB_TMO])) break; if (_sp > XB_SPIN_CAP) { atomicAdd(&(bar)[XB_TMO], 1u); break; } } } } while (0)

struct XcdBarrier {
    unsigned* bar; unsigned x;
    volatile LAS unsigned* st;
};

__device__ __forceinline__ XcdBarrier xcd_barrier_post(unsigned* bar, volatile LAS unsigned* st) {
    XcdBarrier b; b.bar = bar; b.x = xb_xcc_id(); b.st = st;
    if (threadIdx.x == 0) (void)xb_add(&bar[XB_XCNT(b.x)], 1u);
    return b;
}
__device__ __forceinline__ void xcd_barrier_complete(unsigned* bar, unsigned x, unsigned& nloc, unsigned& nx) {
    const unsigned G = gridDim.x * gridDim.y * gridDim.z;
    unsigned sum, cnt, mine, sp = 0u;
    for (;;) {
        sum = 0u; cnt = 0u; mine = 0u;
#pragma unroll
        for (unsigned j = 0; j < 16; ++j) { const unsigned c = xb_ld(&bar[XB_XCNT(j)]); sum += c; cnt += (c > 0u) ? 1u : 0u; mine = (j == x) ? c : mine; }
        if (sum == G) break;
        __builtin_amdgcn_s_sleep(1);
        if ((++sp & 255u) == 0u) { if (xb_ld(&bar[XB_TMO])) break; if (sp > XB_SPIN_CAP) { atomicAdd(&bar[XB_TMO], 1u); break; } }
    }
    nloc = mine > 0u ? mine : 1u; nx = cnt > 0u ? cnt : 1u;
}

__device__ __forceinline__ void xcd_barrier(const XcdBarrier& b) {
    asm volatile("s_waitcnt vmcnt(0)" ::: "memory");
    __syncthreads();
    if (threadIdx.x == 0) {
        unsigned* bar = b.bar;
        __builtin_amdgcn_s_waitcnt(0);
        unsigned nloc = b.st[0], nx = b.st[1];
        if (nloc == 0u) { xcd_barrier_complete(bar, b.x, nloc, nx); b.st[0] = nloc; b.st[1] = nx; }
        const unsigned old = xb_add(&bar[XB_XSUB(b.x)], 1u);
        const unsigned gen = old / nloc;
        if (old + 1u == (gen + 1u) * nloc) {
            __builtin_amdgcn_fence(__ATOMIC_RELEASE, "agent");
            asm volatile("s_waitcnt vmcnt(0)" ::: "memory");
            const unsigned og = xb_add(&bar[XB_TOP], 1u);
            const unsigned tg = og / nx;
            if (og + 1u == (tg + 1u) * nx) xb_add(&bar[XB_TOPGEN], 1u);
            else XB_SPIN(xb_ld(&bar[XB_TOPGEN]) == tg, bar);
            __builtin_amdgcn_fence(__ATOMIC_ACQUIRE, "agent");
            xb_add(&bar[XB_XGEN(b.x)], 1u);
            asm volatile("s_waitcnt vmcnt(0)" ::: "memory");
        } else {
            XB_SPIN(xb_ld(&bar[XB_XGEN(b.x)]) == gen, bar);
            __builtin_amdgcn_fence(__ATOMIC_ACQUIRE, "agent");
            asm volatile("s_waitcnt vmcnt(0)" ::: "memory");
        }
    }
    __syncthreads();
}
typedef unsigned u32x2g __attribute__((ext_vector_type(2)));
typedef float f32x2g __attribute__((ext_vector_type(2)));
__device__ __forceinline__ float shx(float v, int o, int lane) { return __builtin_bit_cast(float, __builtin_amdgcn_ds_bpermute((lane ^ o) << 2, __builtin_bit_cast(int, v))); }
__device__ __forceinline__ float wave_sum(float v, int lane) {
    (void)lane;
#define WS_DPP(CTRL) v += __builtin_bit_cast(float, __builtin_amdgcn_update_dpp(0, __builtin_bit_cast(int, v), CTRL, 0xF, 0xF, true))
    WS_DPP(0xB1); WS_DPP(0x4E); WS_DPP(0x141); WS_DPP(0x140);
#undef WS_DPP
    const int x = __builtin_bit_cast(int, v);
    const float s0 = __builtin_bit_cast(float, __builtin_amdgcn_readlane(x, 0)), s1 = __builtin_bit_cast(float, __builtin_amdgcn_readlane(x, 16));
    const float s2 = __builtin_bit_cast(float, __builtin_amdgcn_readlane(x, 32)), s3 = __builtin_bit_cast(float, __builtin_amdgcn_readlane(x, 48));
    return (s0 + s1) + (s2 + s3);
}
__device__ __forceinline__ void unpack8(const v4u w, float (&f)[8]) { f[0] = pg8::bf_lo(w.x); f[1] = pg8::bf_hi(w.x); f[2] = pg8::bf_lo(w.y); f[3] = pg8::bf_hi(w.y); f[4] = pg8::bf_lo(w.z); f[5] = pg8::bf_hi(w.z); f[6] = pg8::bf_lo(w.w); f[7] = pg8::bf_hi(w.w); }
__device__ __forceinline__ v4u pack8(const float (&f)[8]) { v4u o; o.x = pk2(f[0], f[1]); o.y = pk2(f[2], f[3]); o.z = pk2(f[4], f[5]); o.w = pk2(f[6], f[7]); return o; }
__device__ __forceinline__ float gelu_tanh(float x) { return x * pg8::sigm(1.5957691216057308f * (x + 0.044715f * x * x * x)); }
__device__ __forceinline__ void load8f(const float* p, float (&f)[8]) { const f32x4 a = *(const f32x4*)p, b = *(const f32x4*)(p + 4); f[0] = a[0]; f[1] = a[1]; f[2] = a[2]; f[3] = a[3]; f[4] = b[0]; f[5] = b[1]; f[6] = b[2]; f[7] = b[3]; }
__device__ __forceinline__ void store8f(float* p, const float (&f)[8]) { *(f32x4*)p = (f32x4){f[0], f[1], f[2], f[3]}; *(f32x4*)(p + 4) = (f32x4){f[4], f[5], f[6], f[7]}; }

struct P0Item { const float* W; bf16* WT; const float* gain; int K, N, r, ldw, glu; };
__device__ __forceinline__ void p0_item_load(const P0Item& d, float (&v)[32], float (&g)[8], int lane) {
    const int nblk = d.N / 32, kb = d.r / nblk, nb = d.r % nblk; const float* src = d.W + (size_t)(64 * kb + (lane >> 5)) * d.N + 32 * nb + (lane & 31);
#pragma unroll
    for (int i = 0; i < 32; ++i) v[i] = src[(size_t)(2 * i) * d.N];
    if (d.gain) load8f(d.gain + 64 * kb + 8 * (lane & 7), g); else {
#pragma unroll
        for (int i = 0; i < 8; ++i) g[i] = 1.0f; }
}
__device__ __forceinline__ void p0_item_store(const P0Item& d, const float (&v)[32], LAS float* scr, int lane) {
#pragma unroll
    for (int i = 0; i < 32; ++i) scr[(2 * i + (lane >> 5)) * 33 + (lane & 31)] = v[i];
}
__device__ __forceinline__ void p0_item_flush(const P0Item& d, const float (&g)[8], LAS float* scr, int lane) {
    const int nblk = d.N / 32, kb = d.r / nblk, nb = d.r % nblk, k0 = 64 * kb, n0 = 32 * nb;
    LDS_WAIT(); asm volatile("" ::: "memory");
    const int c = lane & 7;
#pragma unroll
    for (int j = 0; j < 4; ++j) { const int n = (lane >> 3) + 8 * j; const LAS float* s = scr + (8 * c) * 33 + n;
        v4u o; o.x = pk2(s[0 * 33] * g[0], s[1 * 33] * g[1]); o.y = pk2(s[2 * 33] * g[2], s[3 * 33] * g[3]); o.z = pk2(s[4 * 33] * g[4], s[5 * 33] * g[5]); o.w = pk2(s[6 * 33] * g[6], s[7 * 33] * g[7]);
        int nr = n0 + n; if (nr < 2 * d.glu) { const int cch = nr < d.glu ? nr : nr - d.glu; nr = 8 * (cch >> 2) + (cch & 3) + (nr < d.glu ? 0 : 4); }
        *(GAS v4u*)(d.WT + (size_t)nr * d.ldw + k0 + 8 * c) = o; }
    LDS_WAIT(); asm volatile("" ::: "memory");
}

__device__ __forceinline__ void p0w_load(const P0Item& d, f32x4 (&v)[8], float (&g)[8], int wave, int lane) {
    const int nblk = d.N / 256, kb = d.r / nblk, nb = d.r % nblk; const float* src = d.W + (size_t)(64 * kb + wave) * d.N + 256 * nb + 4 * lane;
#pragma unroll
    for (int p = 0; p < 8; ++p) v[p] = *(const f32x4*)(src + (size_t)(8 * p) * d.N);
    load8f(d.gain ? d.gain + 64 * kb + 8 * (lane & 7) : d.W, g);
}
__device__ __forceinline__ void p0w_store(const f32x4 (&v)[8], LAS float* T, int wave, int lane) {
#pragma unroll
    for (int p = 0; p < 8; ++p) { LAS float* t = T + (8 * p + wave) * 257 + 4 * lane; t[0] = v[p][0]; t[1] = v[p][1]; t[2] = v[p][2]; t[3] = v[p][3]; }
}
__device__ __forceinline__ void p0w_flush(const P0Item& d, const float (&g_)[8], const LAS float* T, int wave, int lane) {
    const int nblk = d.N / 256, kb = d.r / nblk, nb = d.r % nblk, k0 = 64 * kb, n0 = 256 * nb + 32 * wave;
    const int c = lane & 7; float g[8];
#pragma unroll
    for (int i = 0; i < 8; ++i) g[i] = d.gain ? g_[i] : 1.0f;
#pragma unroll
    for (int j = 0; j < 4; ++j) { const int n = (lane >> 3) + 8 * j; const LAS float* s = T + (8 * c) * 257 + 32 * wave + n;
        v4u o; o.x = pk2(s[0 * 257] * g[0], s[1 * 257] * g[1]); o.y = pk2(s[2 * 257] * g[2], s[3 * 257] * g[3]); o.z = pk2(s[4 * 257] * g[4], s[5 * 257] * g[5]); o.w = pk2(s[6 * 257] * g[6], s[7 * 257] * g[7]);
        int nr = n0 + n; if (nr < 2 * d.glu) { const int cch = nr < d.glu ? nr : nr - d.glu; nr = 8 * (cch >> 2) + (cch & 3) + (nr < d.glu ? 0 : 4); }
        *(GAS v4u*)(d.WT + (size_t)nr * d.ldw + k0 + 8 * c) = o; }
}

template <int S, int MODE> __device__ __forceinline__ void load_row_folded(int row, float* H, const float* SLAB, const bf16* PP, f32x4 (&v)[8], int lane) {
    constexpr int mode = MODE;
    f32x4* hr = (f32x4*)(H + (size_t)row * DM) + lane;
#pragma unroll
    for (int j = 0; j < 8; ++j) v[j] = hr[64 * j];
    if (mode != 0 && row >= MP) {
        const f32x4* sl = (const f32x4*)(SLAB + (size_t)(row - MP) * DM) + lane;
#pragma unroll
        for (int j = 0; j < 8; ++j) { f32x4 a = (f32x4){0.f, 0.f, 0.f, 0.f};
            f32x4 t_[S];
#pragma unroll
            for (int s = 0; s < S; ++s) t_[s] = sl[(size_t)s * (MS * DM / 4) + 64 * j];
#pragma unroll
            for (int s = 0; s < S; ++s) a += t_[s];
            if (mode == 1) v[j] += a;
            else { const u32x2g pw = ((const u32x2g*)(PP + (size_t)row * DM))[lane + 64 * j];
                v[j][0] += pg8::sigm(a[0]) * pg8::bf_lo(pw.x); v[j][1] += pg8::sigm(a[1]) * pg8::bf_hi(pw.x); v[j][2] += pg8::sigm(a[2]) * pg8::bf_lo(pw.y); v[j][3] += pg8::sigm(a[3]) * pg8::bf_hi(pw.y); }
            hr[64 * j] = v[j]; }
    }
}
template <int S, int MODE> __device__ __forceinline__ void rms_row_bf16(int row, float* H, const float* SLAB, const bf16* PP, const float* gain, bf16* orow, int lane) {
    const f32x4* gr = (const f32x4*)gain + lane;
    f32x4 v[8]; float s = 0.f; load_row_folded<S, MODE>(row, H, SLAB, PP, v, lane);
#pragma unroll
    for (int j = 0; j < 8; ++j) s += (v[j][0] * v[j][0] + v[j][1] * v[j][1]) + (v[j][2] * v[j][2] + v[j][3] * v[j][3]);
    const float rstd = 1.0f / sqrtf(wave_sum(s, lane) * (1.f / DM) + EPS);
    u32x2g* o8 = (u32x2g*)orow + lane;
#pragma unroll
    for (int j = 0; j < 8; ++j) { const f32x4 g = gr[64 * j]; u32x2g w; w.x = pk2(v[j][0] * rstd * g[0], v[j][1] * rstd * g[1]); w.y = pk2(v[j][2] * rstd * g[2], v[j][3] * rstd * g[3]); o8[64 * j] = w; }
}
template <int S, int MODE> __device__ __forceinline__ void rms_row_f32(int row, float* H, const float* SLAB, const bf16* PP, const float* gain, float* orow, int lane) {
    const f32x4* gr = (const f32x4*)gain + lane;
    f32x4 v[8]; float s = 0.f; load_row_folded<S, MODE>(row, H, SLAB, PP, v, lane);
#pragma unroll
    for (int j = 0; j < 8; ++j) s += (v[j][0] * v[j][0] + v[j][1] * v[j][1]) + (v[j][2] * v[j][2] + v[j][3] * v[j][3]);
    const float rstd = 1.0f / sqrtf(wave_sum(s, lane) * (1.f / DM) + EPS);
    f32x4* o = (f32x4*)orow + lane;
#pragma unroll
    for (int j = 0; j < 8; ++j) { const f32x4 g = gr[64 * j]; o[64 * j] = v[j] * rstd * g; }
}

__device__ __forceinline__ void rms_row_bf16_to_f32(const bf16* hrow, const float* gain, float* orow, int lane) {
    const u32x2g* hr = (const u32x2g*)hrow + lane; const f32x4* gr = (const f32x4*)gain + lane;
    f32x4 v[8], g[8]; float s = 0.f;
#pragma unroll
    for (int j = 0; j < 8; ++j) g[j] = gr[64 * j];
#pragma unroll
    for (int j = 0; j < 8; ++j) { const u32x2g w = hr[64 * j]; v[j] = (f32x4){pg8::bf_lo(w.x), pg8::bf_hi(w.x), pg8::bf_lo(w.y), pg8::bf_hi(w.y)}; s += (v[j][0] * v[j][0] + v[j][1] * v[j][1]) + (v[j][2] * v[j][2] + v[j][3] * v[j][3]); }
    const float rstd = 1.0f / sqrtf(wave_sum(s, lane) * (1.f / DM) + EPS);
    f32x4* o = (f32x4*)orow + lane;
#pragma unroll
    for (int j = 0; j < 8; ++j) o[64 * j] = v[j] * rstd * g[j];
}
__device__ __forceinline__ void rms_rows_bf16_to_f32(const bf16* H, const float* gain, float* O, int row0, int stride, int nrows, int lane) {
    if (row0 >= nrows) return;
    const f32x4* gr = (const f32x4*)gain + lane; f32x4 g[8]; u32x2g wr_[8], wn_[8];
#pragma unroll
    for (int j = 0; j < 8; ++j) { wr_[j] = ((const u32x2g*)(H + (size_t)row0 * DM) + lane)[64 * j]; g[j] = gr[64 * j]; }
    for (int row = row0; row < nrows; row += stride) {
        const bool more = row + stride < nrows; const int nx = more ? row + stride : row;
#pragma unroll
        for (int j = 0; j < 8; ++j) wn_[j] = ((const u32x2g*)(H + (size_t)nx * DM) + lane)[64 * j];
        f32x4 v[8]; float s = 0.f;
#pragma unroll
        for (int j = 0; j < 8; ++j) { const u32x2g w = wr_[j]; v[j] = (f32x4){pg8::bf_lo(w.x), pg8::bf_hi(w.x), pg8::bf_lo(w.y), pg8::bf_hi(w.y)}; s += (v[j][0] * v[j][0] + v[j][1] * v[j][1]) + (v[j][2] * v[j][2] + v[j][3] * v[j][3]); }
        const float rstd = 1.0f / sqrtf(wave_sum(s, lane) * (1.f / DM) + EPS);
        f32x4* o = (f32x4*)(O + (size_t)row * DM) + lane;
#pragma unroll
        for (int j = 0; j < 8; ++j) o[64 * j] = v[j] * rstd * g[j];
#pragma unroll
        for (int j = 0; j < 8; ++j) wr_[j] = wn_[j];
    }
}
template <int S> __device__ __forceinline__ void sample_row_fix_t(int rs, const bf16* SLAB, const pg8::ssq_t* SSi, bf16* T, int wave, int lane) {
    const int c = (wave * 64 + lane) * 16; const float rsi = pg8::rstd_of(pg8::ss_load(SSi + MP + rs));
    float a[16];
#pragma unroll
    for (int i = 0; i < 16; ++i) a[i] = 0.f;
    v4u t_[S][2];
#pragma unroll
    for (int s = 0; s < S; ++s) { const v4u* sp = (const v4u*)(SLAB + ((size_t)s * MS + rs) * DFF + c); t_[s][0] = sp[0]; t_[s][1] = sp[1]; }
#pragma unroll
    for (int s = 0; s < S; ++s) { float f[8]; unpack8(t_[s][0], f);
#pragma unroll
        for (int i = 0; i < 8; ++i) a[i] += f[i];
        unpack8(t_[s][1], f);
#pragma unroll
        for (int i = 0; i < 8; ++i) a[8 + i] += f[i]; }
    unsigned long long* dst = (unsigned long long*)(T + (size_t)(MP + rs) * LD_T + c);
#pragma unroll
    for (int g = 0; g < 4; ++g) { float r[4];
#pragma unroll
        for (int i = 0; i < 4; ++i) { const float v = fmaxf(a[4 * g + i] * rsi, 0.f); r[i] = v * v; }
        __hip_atomic_store(dst + g, (unsigned long long)pk2(r[0], r[1]) | ((unsigned long long)pk2(r[2], r[3]) << 32), __ATOMIC_RELAXED, __HIP_MEMORY_SCOPE_AGENT); }
}
template <int S, int MODE, bool OUTF32> __device__ __forceinline__ void sample_rows_fix(int rs0, int dr, bool n2, int parity, const bf16* Hin, const bf16* SLAB, const bf16* PP, const pg8::ssq_t* SSi, bf16* HB, pg8::ssq_t* SSo, const float* gain, float* outf, LAS float* red, int wave, int lane) {
    const int q = wave * 64 + lane;
    f32x4 v[2]; f32x4 a[2]; u32x2g pw[2]; float rsi[2];
#pragma unroll
    for (int r = 0; r < 2; ++r) { v[r] = (f32x4){0.f, 0.f, 0.f, 0.f}; a[r] = v[r]; pw[r] = (u32x2g){0u, 0u}; rsi[r] = 0.f; }
    constexpr int SC = S < 8 ? S : 8;
#pragma unroll
    for (int r = 0; r < 2; ++r) if (r == 0 || n2) { const int rs = rs0 + r * dr, row = MP + rs;
        { const u32x2g hw = ((const u32x2g*)(Hin + (size_t)row * DM))[q]; v[r] = (f32x4){pg8::bf_lo(hw.x), pg8::bf_hi(hw.x), pg8::bf_lo(hw.y), pg8::bf_hi(hw.y)}; }
        if (MODE == 2) { pw[r] = ((const u32x2g*)(PP + (size_t)row * DM))[q]; rsi[r] = pg8::rstd_of(pg8::ss_load(SSi + row)); } }
    if (MODE != 0) {
#pragma unroll
        for (int s0 = 0; s0 < S; s0 += SC) { f32x4 t_[2][SC];
#pragma unroll
            for (int r = 0; r < 2; ++r) if (r == 0 || n2) { const u32x2g* sl = (const u32x2g*)(SLAB + (size_t)(rs0 + r * dr) * DM) + q;
#pragma unroll
                for (int s = 0; s < SC; ++s) { const u32x2g w = sl[(size_t)(s0 + s) * (MS * DM / 4)]; t_[r][s] = (f32x4){pg8::bf_lo(w.x), pg8::bf_hi(w.x), pg8::bf_lo(w.y), pg8::bf_hi(w.y)}; } }
#pragma unroll
            for (int r = 0; r < 2; ++r) if (r == 0 || n2) {
#pragma unroll
                for (int s = 0; s < SC; ++s) a[r] += t_[r][s]; } } }
    float ss[2];
#pragma unroll
    for (int r = 0; r < 2; ++r) { ss[r] = 0.f; if (r == 0 || n2) { const int row = MP + rs0 + r * dr;
        if (MODE != 0) {
            if (MODE == 1) v[r] += a[r];
            else { a[r] = a[r] * rsi[r];
                v[r][0] += pg8::sigm(a[r][0]) * pg8::bf_lo(pw[r].x); v[r][1] += pg8::sigm(a[r][1]) * pg8::bf_hi(pw[r].x); v[r][2] += pg8::sigm(a[r][2]) * pg8::bf_lo(pw[r].y); v[r][3] += pg8::sigm(a[r][3]) * pg8::bf_hi(pw[r].y); }
            }
        ss[r] = (v[r][0] * v[r][0] + v[r][1] * v[r][1]) + (v[r][2] * v[r][2] + v[r][3] * v[r][3]); } }
#pragma unroll
    for (int o = 1; o < 64; o <<= 1) { ss[0] += shx(ss[0], o, lane); ss[1] += shx(ss[1], o, lane); }
    LAS float* rd = red + 16 * (parity & 1);
    if (lane == 0) { rd[wave] = ss[0]; rd[8 + wave] = ss[1]; }
    __syncthreads();
#pragma unroll
    for (int r = 0; r < 2; ++r) if (r == 0 || n2) { const int row = MP + rs0 + r * dr; float tot = 0.f;
#pragma unroll
        for (int w = 0; w < 8; ++w) tot += rd[8 * r + w];
        if (OUTF32) { const float rstd = 1.0f / sqrtf(tot * (1.f / DM) + EPS); const f32x4 g = ((const f32x4*)gain)[q]; ((f32x4*)(outf + (size_t)row * DM))[q] = v[r] * rstd * g; }
        else { const unsigned long long w = (unsigned long long)pk2(v[r][0], v[r][1]) | ((unsigned long long)pk2(v[r][2], v[r][3]) << 32);
            __hip_atomic_store((unsigned long long*)(HB + (size_t)row * DM) + q, w, __ATOMIC_RELAXED, __HIP_MEMORY_SCOPE_AGENT); if (wave == 0 && lane == 0) pg8::ss_store(SSo + row, tot); } }
}
__device__ __forceinline__ void conv_row(int l, int row, const bf16* z, const float* cache_conv, const float* conv_w, const float* conv_b, const float* ln_g, const float* ln_b, bf16* ya, float* out, int lane) {
    const bool samp = row >= MP; const int b = samp ? (row - MP) >> 5 : row >> 12, t = samp ? (row - MP) & 31 : row & 4095;
    float acc[2][8];
#pragma unroll
    for (int hh = 0; hh < 2; ++hh) load8f(conv_b + hh * 512 + 8 * lane, acc[hh]);
    for (int j = 0; j < CONVW; ++j) {
        const int tt = t - 30 + j;
        if (tt < 0 && !samp) continue;
#pragma unroll
        for (int hh = 0; hh < 2; ++hh) {
            const int c = hh * 512 + 8 * lane; float a[8], w[8];
            if (tt >= 0) { const bf16* zr = z + (size_t)(row - 30 + j) * ZP + ZA + c; float x[8], g[8]; unpack8(*(const v4u*)zr, x); unpack8(*(const v4u*)(zr + CONVD), g);
#pragma unroll
                for (int i = 0; i < 8; ++i) a[i] = x[i] * pg8::sigm(g[i]);
            } else load8f(cache_conv + (((size_t)l * DBATCH + b) * 30 + (30 + tt)) * CONVD + c, a);
            load8f(conv_w + (size_t)j * CONVD + c, w);
#pragma unroll
            for (int i = 0; i < 8; ++i) acc[hh][i] += a[i] * w[i];
            if (j == CONVW - 1) {
                if (!samp && t >= SEQ - 30) store8f(out + O_CSP + (((size_t)l * PBATCH + b) * 30 + (t - (SEQ - 30))) * CONVD + c, a);
                if (samp && t >= 2) store8f(out + O_CSS + (((size_t)l * DBATCH + b) * 30 + (t - 2)) * CONVD + c, a);
            }
        }
    }
    float s = 0.f;
#pragma unroll
    for (int hh = 0; hh < 2; ++hh)
#pragma unroll
        for (int i = 0; i < 8; ++i) s += acc[hh][i];
    const float mean = wave_sum(s, lane) * (1.f / CONVD); float q = 0.f;
#pragma unroll
    for (int hh = 0; hh < 2; ++hh)
#pragma unroll
        for (int i = 0; i < 8; ++i) { acc[hh][i] -= mean; q += acc[hh][i] * acc[hh][i]; }
    const float rstd = 1.0f / sqrtf(wave_sum(q, lane) * (1.f / CONVD) + EPS);
#pragma unroll
    for (int hh = 0; hh < 2; ++hh) { const int c = hh * 512 + 8 * lane; float g[8], bb[8], y[8]; load8f(ln_g + c, g); load8f(ln_b + c, bb);
#pragma unroll
        for (int i = 0; i < 8; ++i) { const float v = acc[hh][i] * rstd * g[i] + bb[i]; y[i] = v * pg8::sigm(v); }
        *(v4u*)(ya + (size_t)row * CONVD + c) = pack8(y); }
}
__device__ __forceinline__ void gmlp_v_row(int l, int row, const bf16* z, const float* ln_g, const float* ln_b, bf16* vb, float* out, int lane) {
    float x[2][8], g[2][8], bb[2][8]; float s = 0.f; v4u xr[2];
#pragma unroll
    for (int hh = 0; hh < 2; ++hh) { const int c = hh * 512 + 8 * lane; xr[hh] = *(const v4u*)(z + (size_t)row * ZP + ZB + GMD + c); load8f(ln_g + c, g[hh]); load8f(ln_b + c, bb[hh]); }
#pragma unroll
    for (int hh = 0; hh < 2; ++hh) { unpack8(xr[hh], x[hh]);
#pragma unroll
        for (int i = 0; i < 8; ++i) { x[hh][i] = gelu_tanh(x[hh][i]); s += x[hh][i]; } }
    const float mean = wave_sum(s, lane) * (1.f / GMD); float q = 0.f;
#pragma unroll
    for (int hh = 0; hh < 2; ++hh)
#pragma unroll
        for (int i = 0; i < 8; ++i) { x[hh][i] -= mean; q += x[hh][i] * x[hh][i]; }
    const float rstd = 1.0f / sqrtf(wave_sum(q, lane) * (1.f / GMD) + EPS);
#pragma unroll
    for (int hh = 0; hh < 2; ++hh) { const int c = hh * 512 + 8 * lane; float y[8];
#pragma unroll
        for (int i = 0; i < 8; ++i) y[i] = x[hh][i] * rstd * g[hh][i] + bb[hh][i];
        *(v4u*)(vb + (size_t)row * GMD + c) = pack8(y);
        if (row >= MP) store8f(out + O_GV + ((size_t)l * MS + (row - MP)) * GMD + c, y); }
}
__device__ __forceinline__ void gmlp_v_rows(int l, int row0, int stride, int nrows, const bf16* z, const float* ln_g, const float* ln_b, bf16* vb, float* out, int lane) {
    if (row0 >= nrows) return;
    float g[2][8], bb[2][8]; v4u xr[2], xn[2];
#pragma unroll
    for (int hh = 0; hh < 2; ++hh) { const int c = hh * 512 + 8 * lane; xr[hh] = *(const v4u*)(z + (size_t)row0 * ZP + ZB + GMD + c); load8f(ln_g + c, g[hh]); load8f(ln_b + c, bb[hh]); }
    for (int row = row0; row < nrows; row += stride) {
        const bool more = row + stride < nrows; const int nx = more ? row + stride : row;
#pragma unroll
        for (int hh = 0; hh < 2; ++hh) xn[hh] = *(const v4u*)(z + (size_t)nx * ZP + ZB + GMD + hh * 512 + 8 * lane);
        float x[2][8]; float s = 0.f;
#pragma unroll
        for (int hh = 0; hh < 2; ++hh) { unpack8(xr[hh], x[hh]);
#pragma unroll
            for (int i = 0; i < 8; ++i) { x[hh][i] = gelu_tanh(x[hh][i]); s += x[hh][i]; } }
        const float mean = wave_sum(s, lane) * (1.f / GMD); float q = 0.f;
#pragma unroll
        for (int hh = 0; hh < 2; ++hh)
#pragma unroll
            for (int i = 0; i < 8; ++i) { x[hh][i] -= mean; q += x[hh][i] * x[hh][i]; }
        const float rstd = 1.0f / sqrtf(wave_sum(q, lane) * (1.f / GMD) + EPS);
#pragma unroll
        for (int hh = 0; hh < 2; ++hh) { const int c = hh * 512 + 8 * lane; float y[8];
#pragma unroll
            for (int i = 0; i < 8; ++i) y[i] = x[hh][i] * rstd * g[hh][i] + bb[hh][i];
            *(v4u*)(vb + (size_t)row * GMD + c) = pack8(y);
            if (row >= MP) store8f(out + O_GV + ((size_t)l * MS + (row - MP)) * GMD + c, y); }
        xr[0] = xn[0]; xr[1] = xn[1];
    }
}
__device__ __forceinline__ void gmlp_spatial_row(int row, const bf16* z, const bf16* vb, const float* ws, const float* bs, bf16* yb, int lane) {
    const bool samp = row >= MP; const int t = samp ? (row - MP) & 31 : row & 4095; const int tl = samp ? t : (t & 127); const int chunk0 = row - tl;
    float acc[2][8];
#pragma unroll
    for (int hh = 0; hh < 2; ++hh)
#pragma unroll
        for (int i = 0; i < 8; ++i) acc[hh][i] = 0.f;
    const int g0 = lane >> 4;
    for (int s = 0; s <= tl; ++s) {
#pragma unroll
        for (int hh = 0; hh < 2; ++hh) { const int c = hh * 512 + 8 * lane; const float w = ws[((size_t)(hh * 4 + g0) * 128 + tl) * 128 + s]; float v[8]; unpack8(*(const v4u*)(vb + (size_t)(chunk0 + s) * GMD + c), v);
#pragma unroll
            for (int i = 0; i < 8; ++i) acc[hh][i] += w * v[i]; }
    }
#pragma unroll
    for (int hh = 0; hh < 2; ++hh) { const int c = hh * 512 + 8 * lane; const float bias = bs[(hh * 4 + g0) * 128 + tl]; float u[8], y[8]; unpack8(*(const v4u*)(z + (size_t)row * ZP + ZB + c), u);
#pragma unroll
        for (int i = 0; i < 8; ++i) y[i] = gelu_tanh(u[i]) * (acc[hh][i] + bias);
        *(v4u*)(yb + (size_t)row * GMD + c) = pack8(y); }
}
__device__ __forceinline__ void attn_task(int l, int row, int hh, const bf16* z, const float* ck, const float* cv, const float* tab, bf16* o, int lane) {
    const float scale = 0.08838834764831845f;
    const unsigned qw = *(const unsigned*)(z + (size_t)row * ZP + ZQ + hh * HDIM + 2 * lane);
    const float q0 = pg8::bf_lo(qw) * scale, q1 = pg8::bf_hi(qw) * scale;
    float m = -3.0e38f, lsum = 0.f, o0 = 0.f, o1 = 0.f;
    const float* tb = tab + hh * 257;
    const int col = hh * HDIM + 2 * lane;
    if (row < MP) {
        const int b = row >> 12, t = row & 4095, n = t >> 6;
        int p0 = (n - 8) * 64; if (p0 < 0) p0 = 0; const int p1 = n * 64 + 64;
        for (int p = p0; p < p1; ++p) {
            const bf16* kr = z + (size_t)(b * SEQ + p) * ZP;
            const unsigned kw = *(const unsigned*)(kr + ZK + col), vw = *(const unsigned*)(kr + ZV + col);
            float s = wave_sum(q0 * pg8::bf_lo(kw) + q1 * pg8::bf_hi(kw), lane);
            int rel = t - p; rel = rel < -128 ? -128 : (rel > 128 ? 128 : rel);
            s += tb[rel + 128];
            const float mn = fmaxf(m, s), corr = __expf(m - mn), pe = __expf(s - mn);
            lsum = lsum * corr + pe; o0 = o0 * corr + pe * pg8::bf_lo(vw); o1 = o1 * corr + pe * pg8::bf_hi(vw); m = mn;
        }
    } else {
        const int b = (row - MP) >> 5, t = (row - MP) & 31;
        for (int kidx = 0; kidx < WCACHE + DSEQ; ++kidx) {
            float k0, k1, v0, v1;
            if (kidx < WCACHE) { const size_t off = ((((size_t)l * DBATCH + b) * WCACHE + kidx) * NHEAD + hh) * HDIM + 2 * lane;
                const f32x2g kk = *(const f32x2g*)(ck + off), vv = *(const f32x2g*)(cv + off); k0 = kk.x; k1 = kk.y; v0 = vv.x; v1 = vv.y; }
            else { const bf16* kr = z + (size_t)(MP + b * DSEQ + (kidx - WCACHE)) * ZP; const unsigned kw = *(const unsigned*)(kr + ZK + col), vw = *(const unsigned*)(kr + ZV + col);
                k0 = pg8::bf_lo(kw); k1 = pg8::bf_hi(kw); v0 = pg8::bf_lo(vw); v1 = pg8::bf_hi(vw); }
            float s = wave_sum(q0 * k0 + q1 * k1, lane);
            int rel = t + WCACHE - kidx; rel = rel < -128 ? -128 : (rel > 128 ? 128 : rel);
            s += tb[rel + 128];
            const float mn = fmaxf(m, s), corr = __expf(m - mn), pe = __expf(s - mn);
            lsum = lsum * corr + pe; o0 = o0 * corr + pe * v0; o1 = o1 * corr + pe * v1; m = mn;
        }
    }
    const float inv = 1.0f / lsum;
    *(unsigned*)(o + (size_t)row * ATD + col) = pk2(o0 * inv, o1 * inv);
}
__device__ __forceinline__ void kv_rows(int l, int row, const bf16* z, float* out, int lane) {
    const bool samp = row >= MP; size_t ko, vo;
    if (samp) { ko = O_KS + ((size_t)l * MS + (row - MP)) * ATD; vo = O_VS + ((size_t)l * MS + (row - MP)) * ATD; }
    else { const int b = row >> 12, t = row & 4095; if (t < SEQ - WCACHE) return; ko = O_KP + (((size_t)l * PBATCH + b) * WCACHE + (t - (SEQ - WCACHE))) * ATD; vo = O_VP + (((size_t)l * PBATCH + b) * WCACHE + (t - (SEQ - WCACHE))) * ATD; }
    v4u kq[2], vq[2];
#pragma unroll
    for (int hh = 0; hh < 2; ++hh) { const int c = hh * 512 + 8 * lane; kq[hh] = *(const v4u*)(z + (size_t)row * ZP + ZK + c); vq[hh] = *(const v4u*)(z + (size_t)row * ZP + ZV + c); }
#pragma unroll
    for (int hh = 0; hh < 2; ++hh) { const int c = hh * 512 + 8 * lane; float f[8];
        unpack8(kq[hh], f); store8f(out + ko + c, f);
        unpack8(vq[hh], f); store8f(out + vo + c, f); }
}
constexpr int CONV_R = 35, RUNS_PB = (SEQ + CONV_R - 1) / CONV_R, CONV_RUNS = PBATCH * RUNS_PB + DBATCH, CONV_WUNITS = CONV_RUNS * 8;
static_assert(CONV_WUNITS <= 2048, "one conv wave-unit per wave");
__device__ __forceinline__ f32x2g glu2w(unsigned x) { f32x2g a; a.x = pg8::bf_lo(x); a.y = pg8::bf_hi(x); return a; }
constexpr int CONV_G = 8;
__device__ __forceinline__ void conv_unit(int l, int wu, const bf16* Z, const float* cache_conv, const float* conv_w, const float* conv_b, float* Y, float* out, int lane) {
    const int run = wu >> 3, c = (wu & 7) * 128 + 2 * lane;
    const bool samp = run >= PBATCH * RUNS_PB;
    int b, t0, len;
    if (!samp) { b = run / RUNS_PB; t0 = (run % RUNS_PB) * CONV_R; len = SEQ - t0 < CONV_R ? SEQ - t0 : CONV_R; } else { b = run - PBATCH * RUNS_PB; t0 = 0; len = DSEQ; }
    const int row0 = samp ? MP + b * DSEQ : b * SEQ + t0;
    const bf16* zc = Z + (size_t)row0 * ZP + ZA + c;
    unsigned xq[CONV_G];
#pragma unroll
    for (int u = 0; u < CONV_G; ++u) { const int ii = u < len ? u : len - 1; xq[u] = *(const unsigned*)(zc + (size_t)ii * ZP); }
    f32x2g w[CONVW], win[CONVW - 1 + CONV_G];
    { const float* wp = conv_w + c;
#pragma unroll
      for (int j = 0; j < CONVW; ++j) { w[j] = *(const f32x2g*)wp; wp += CONVD; asm volatile("" : "+v"(wp)); } }
    const f32x2g bias = *(const f32x2g*)(conv_b + c);
    if (samp) {
#pragma unroll
        for (int j = 0; j < CONVW - 1; ++j) win[j] = *(const f32x2g*)(cache_conv + (((size_t)l * DBATCH + b) * 30 + j) * CONVD + c);
    } else if (t0 == 0) {
#pragma unroll
        for (int j = 0; j < CONVW - 1; ++j) win[j] = (f32x2g){0.f, 0.f};
    } else {
        unsigned xw[CONVW - 1];
#pragma unroll
        for (int j = 0; j < CONVW - 1; ++j) xw[j] = *(const unsigned*)(zc + ((ptrdiff_t)j - 30) * ZP);
#pragma unroll
        for (int j = 0; j < CONVW - 1; ++j) win[j] = glu2w(xw[j]);
    }
    for (int i0 = 0; i0 < len; i0 += CONV_G) {
        unsigned xn[CONV_G];
#pragma unroll
        for (int u = 0; u < CONV_G; ++u) { int ii = i0 + CONV_G + u; ii = ii < len ? ii : len - 1; xn[u] = *(const unsigned*)(zc + (size_t)ii * ZP); }
#pragma unroll
        for (int u = 0; u < CONV_G; ++u) win[CONVW - 1 + u] = glu2w(xq[u]);
#pragma unroll
        for (int u = 0; u < CONV_G; ++u) { const int i = i0 + u;
            if (i < len) { const int t = t0 + i, row = row0 + i;
                f32x2g y = bias;
#pragma unroll
                for (int j = 0; j < CONVW; ++j) y += win[u + j] * w[j];
                *(f32x2g*)(Y + (size_t)row * CONVD + c) = y;
                if (!samp && t >= SEQ - 30) *(f32x2g*)(out + O_CSP + (((size_t)l * PBATCH + b) * 30 + (t - (SEQ - 30))) * CONVD + c) = win[CONVW - 1 + u];
                if (samp && t >= 2) *(f32x2g*)(out + O_CSS + (((size_t)l * DBATCH + b) * 30 + (t - 2)) * CONVD + c) = win[CONVW - 1 + u]; } }
#pragma unroll
        for (int j = 0; j < CONVW - 1; ++j) win[j] = win[j + CONV_G];
#pragma unroll
        for (int u = 0; u < CONV_G; ++u) xq[u] = xn[u];
    }
}
__device__ __forceinline__ void conv_ln_row(int row, const float* Y, const float* ln_g, const float* ln_b, bf16* ya, int lane) {
    float x[2][8], g[2][8], bb[2][8]; float s = 0.f;
#pragma unroll
    for (int hh = 0; hh < 2; ++hh) { load8f(Y + (size_t)row * CONVD + hh * 512 + 8 * lane, x[hh]); load8f(ln_g + hh * 512 + 8 * lane, g[hh]); load8f(ln_b + hh * 512 + 8 * lane, bb[hh]); }
#pragma unroll
    for (int hh = 0; hh < 2; ++hh)
#pragma unroll
        for (int i = 0; i < 8; ++i) s += x[hh][i];
    const float mean = wave_sum(s, lane) * (1.f / CONVD); float q = 0.f;
#pragma unroll
    for (int hh = 0; hh < 2; ++hh)
#pragma unroll
        for (int i = 0; i < 8; ++i) { x[hh][i] -= mean; q += x[hh][i] * x[hh][i]; }
    const float rstd = 1.0f / sqrtf(wave_sum(q, lane) * (1.f / CONVD) + EPS);
#pragma unroll
    for (int hh = 0; hh < 2; ++hh) { const int c = hh * 512 + 8 * lane; float y[8];
#pragma unroll
        for (int i = 0; i < 8; ++i) { const float v = x[hh][i] * rstd * g[hh][i] + bb[hh][i]; y[i] = v * pg8::sigm(v); }
        *(v4u*)(ya + (size_t)row * CONVD + c) = pack8(y); }
}
__device__ __forceinline__ void conv_ln_rows(int rowb, int i0, int stride, int len, const float* Y, const float* ln_g, const float* ln_b, bf16* ya, int lane) {
    if (i0 >= len) return;
    float xr[2][8], xn[2][8], g[2][8], bb[2][8];
#pragma unroll
    for (int hh = 0; hh < 2; ++hh) { load8f(Y + (size_t)(rowb + i0) * CONVD + hh * 512 + 8 * lane, xr[hh]); load8f(ln_g + hh * 512 + 8 * lane, g[hh]); load8f(ln_b + hh * 512 + 8 * lane, bb[hh]); }
    for (int i = i0; i < len; i += stride) { const int row = rowb + i; const bool more = i + stride < len; const int nxr = more ? row + stride : row;
#pragma unroll
        for (int hh = 0; hh < 2; ++hh) load8f(Y + (size_t)nxr * CONVD + hh * 512 + 8 * lane, xn[hh]);
        float x[2][8]; float s = 0.f;
#pragma unroll
        for (int hh = 0; hh < 2; ++hh)
#pragma unroll
            for (int k = 0; k < 8; ++k) { x[hh][k] = xr[hh][k]; s += x[hh][k]; }
        const float mean = wave_sum(s, lane) * (1.f / CONVD); float q = 0.f;
#pragma unroll
        for (int hh = 0; hh < 2; ++hh)
#pragma unroll
            for (int k = 0; k < 8; ++k) { x[hh][k] -= mean; q += x[hh][k] * x[hh][k]; }
        const float rstd = 1.0f / sqrtf(wave_sum(q, lane) * (1.f / CONVD) + EPS);
#pragma unroll
        for (int hh = 0; hh < 2; ++hh) { const int c = hh * 512 + 8 * lane; float y[8];
#pragma unroll
            for (int k = 0; k < 8; ++k) { const float v = x[hh][k] * rstd * g[hh][k] + bb[hh][k]; y[k] = v * pg8::sigm(v); }
            *(v4u*)(ya + (size_t)row * CONVD + c) = pack8(y); }
#pragma unroll
        for (int hh = 0; hh < 2; ++hh)
#pragma unroll
            for (int k = 0; k < 8; ++k) xr[hh][k] = xn[hh][k];
    }
}
namespace att {
using bf16x8 = __attribute__((ext_vector_type(8))) short;
using s16x4  = __attribute__((ext_vector_type(4))) short;
using f32x16 = __attribute__((ext_vector_type(16))) float;
using u32x4  = __attribute__((ext_vector_type(4))) unsigned;
constexpr float SCALE = 0.088388347648318440f, INV_SCALE = 11.313708498984761f, THR = 8.f;
constexpr int SHM_T = 16384;
constexpr int LDS_V = 0, LDS_K = 2 * SHM_T, LDS_WS = 4 * SHM_T, LDS_TAB = LDS_WS + 8 * 256, LDS_END = LDS_TAB + 1040;
#define KSWZ(row, colB) ((row) * 256 + ((colB) ^ (((row) & 7) << 4)))
#define SBAR() __builtin_amdgcn_sched_barrier(0)
__device__ __forceinline__ int crow(int r, int hi) { return (r & 3) + 8 * (r >> 2) + 4 * hi; }
__device__ __forceinline__ unsigned cvtpk(float lo, float hi) { unsigned r; asm volatile("v_cvt_pk_bf16_f32 %0, %1, %2" : "=v"(r) : "v"(lo), "v"(hi)); return r; }
__device__ __forceinline__ void partialSM(f32x16& p0, f32x16& p1, float& m_reg, float& mn, float& alpha) {
  constexpr float C = SCALE * 1.4426950408889634f;
  float pmax = p0[0];
#pragma unroll
  for (int r = 1; r < 16; ++r) pmax = fmaxf(pmax, p0[r]);
#pragma unroll
  for (int r = 0; r < 16; ++r) pmax = fmaxf(pmax, p1[r]);
  { auto rr = __builtin_amdgcn_permlane32_swap(__float_as_uint(pmax), __float_as_uint(pmax), false, false);
    pmax = fmaxf(__uint_as_float(rr[0]), __uint_as_float(rr[1])); }
  if (__builtin_expect(__all(pmax - m_reg <= THR / SCALE), 1)) { mn = m_reg; alpha = 1.f; }
  else { mn = fmaxf(m_reg, pmax); alpha = __builtin_amdgcn_exp2f((m_reg - mn) * C); m_reg = mn; }
  const float mnC = -mn * C;
#pragma unroll
  for (int r = 0; r < 16; ++r) p0[r] = fmaf(p0[r], C, mnC);
#pragma unroll
  for (int r = 0; r < 16; ++r) p1[r] = fmaf(p1[r], C, mnC);
#pragma unroll
  for (int r = 0; r < 16; ++r) p0[r] = __builtin_amdgcn_exp2f(p0[r]);
}
__device__ __forceinline__ void finishSM(f32x16& p0, f32x16& p1, float alpha, float& l_reg, bf16x8& pa0, bf16x8& pa1, bf16x8& pa2, bf16x8& pa3) {
#pragma unroll
  for (int r = 0; r < 16; ++r) p1[r] = __builtin_amdgcn_exp2f(p1[r]);
  float ps = 0;
#pragma unroll
  for (int r = 0; r < 16; ++r) ps += p0[r];
#pragma unroll
  for (int r = 0; r < 16; ++r) ps += p1[r];
  { auto rr = __builtin_amdgcn_permlane32_swap(__float_as_uint(ps), __float_as_uint(ps), false, false);
    ps = __uint_as_float(rr[0]) + __uint_as_float(rr[1]); }
  l_reg = l_reg * alpha + ps;
#define PK4(P, BASE, OUT) do { unsigned a0 = cvtpk(P[BASE + 0], P[BASE + 1]), a1 = cvtpk(P[BASE + 2], P[BASE + 3]);   \
    unsigned b0 = cvtpk(P[BASE + 4], P[BASE + 5]), b1 = cvtpk(P[BASE + 6], P[BASE + 7]);                              \
    auto r0 = __builtin_amdgcn_permlane32_swap(a0, b0, false, false); auto r1 = __builtin_amdgcn_permlane32_swap(a1, b1, false, false); \
    u32x4 w = {r0[0], r1[0], r0[1], r1[1]}; OUT = *reinterpret_cast<bf16x8*>(&w); } while (0)
  PK4(p0, 0, pa0); PK4(p0, 8, pa1); PK4(p1, 0, pa2); PK4(p1, 8, pa3);
#undef PK4
}
__device__ __forceinline__ void qkt(f32x16& p0, f32x16& p1, const char* Ks, const bf16x8* qr, int r32, int hi) {
  p0 = f32x16{}; p1 = f32x16{};
#pragma unroll
  for (int d0 = 0; d0 < 8; ++d0) { const int cb = (d0 * 16 + hi * 8) * 2;
    const bf16x8 b0 = *reinterpret_cast<const bf16x8*>(Ks + KSWZ(r32, cb));
    const bf16x8 b1 = *reinterpret_cast<const bf16x8*>(Ks + KSWZ(32 + r32, cb));
    p0 = __builtin_amdgcn_mfma_f32_32x32x16_bf16(b0, qr[d0], p0, 0, 0, 0);
    p1 = __builtin_amdgcn_mfma_f32_32x32x16_bf16(b1, qr[d0], p1, 0, 0, 0); }
}
__device__ __forceinline__ int v_st(int k, int c) { const int kk = (k & ~0xC) | ((k & 4) << 1) | ((k & 8) >> 1); return ((kk >> 3) * 4 + (c >> 5)) * 512 + ((kk & 7) * 32 + (c & 31)) * 2; }
__device__ __forceinline__ int v_rd_base(int lane) { return ((lane & 3) << 3) | (((lane >> 2) & 3) << 6) | (((lane >> 4) & 1) << 5) | (((lane >> 5) & 1) << 8); }
constexpr int v_rd_off(int d0, int ks, int half) { return d0 * 512 + ks * 4096 + half * 2048; }
template <int OFF> __device__ __forceinline__ s16x4 tr_read(int vb) { s16x4 r; asm volatile("ds_read_b64_tr_b16 %0, %1 offset:%2" : "=&v"(r) : "v"(vb), "i"(OFF) : "memory"); return r; }
template <int D0> __device__ __forceinline__ void pv_one(f32x16& od, int vb, bf16x8 pa0, bf16x8 pa1, bf16x8 pa2, bf16x8 pa3) {
  const s16x4 l0 = tr_read<v_rd_off(D0, 0, 0)>(vb), h0 = tr_read<v_rd_off(D0, 0, 1)>(vb), l1 = tr_read<v_rd_off(D0, 1, 0)>(vb), h1 = tr_read<v_rd_off(D0, 1, 1)>(vb);
  const s16x4 l2 = tr_read<v_rd_off(D0, 2, 0)>(vb), h2 = tr_read<v_rd_off(D0, 2, 1)>(vb), l3 = tr_read<v_rd_off(D0, 3, 0)>(vb), h3 = tr_read<v_rd_off(D0, 3, 1)>(vb);
  asm volatile("s_waitcnt lgkmcnt(0)" ::: "memory"); SBAR();
#define PK(L, H) (bf16x8){L[0], L[1], L[2], L[3], H[0], H[1], H[2], H[3]}
  od = __builtin_amdgcn_mfma_f32_32x32x16_bf16(pa0, PK(l0, h0), od, 0, 0, 0);
  od = __builtin_amdgcn_mfma_f32_32x32x16_bf16(pa1, PK(l1, h1), od, 0, 0, 0);
  od = __builtin_amdgcn_mfma_f32_32x32x16_bf16(pa2, PK(l2, h2), od, 0, 0, 0);
  od = __builtin_amdgcn_mfma_f32_32x32x16_bf16(pa3, PK(l3, h3), od, 0, 0, 0);
#undef PK
}
__device__ __forceinline__ void pv_d0(f32x16* o, int vb, bf16x8 pa0, bf16x8 pa1, bf16x8 pa2, bf16x8 pa3) {
  pv_one<0>(o[0], vb, pa0, pa1, pa2, pa3); pv_one<1>(o[1], vb, pa0, pa1, pa2, pa3); pv_one<2>(o[2], vb, pa0, pa1, pa2, pa3); pv_one<3>(o[3], vb, pa0, pa1, pa2, pa3);
}
__device__ __forceinline__ bf16x8 ld8_bf(const unsigned short* p) { return *reinterpret_cast<const bf16x8*>(p); }
__device__ __forceinline__ bf16x8 ld8_f32(const float* p) { const f32x4 a = *(const f32x4*)p, b = *(const f32x4*)(p + 4);
  u32x4 w = {cvtpk(a[0], a[1]), cvtpk(a[2], a[3]), cvtpk(b[0], b[1]), cvtpk(b[2], b[3])}; return *reinterpret_cast<bf16x8*>(&w); }

constexpr int PART_O = 32 * 128, PART_STRIDE = PART_O + 64;
__device__ __forceinline__ void attn_unit(int l, int u, const unsigned short* Z, const float* ck, const float* cv, const float* tab_l, unsigned short* OB, float* PART, char* lds) {
  int tid_ = threadIdx.x; asm volatile("" : "+v"(tid_));
  const int tid = tid_, wid = __builtin_amdgcn_readfirstlane(tid >> 6), lane = tid & 63, r32 = lane & 31, hi = lane >> 5;
  const bool samp = u >= 256;
  const int b = samp ? (u - 256) >> 4 : u >> 7, h = samp ? ((u - 256) >> 1) & 7 : (u >> 4) & 7, c0 = samp ? 0 : (u & 15) * 4, half = samp ? (u - 256) & 1 : 0;
  char* V_lds = lds + LDS_V; char* K_lds = lds + LDS_K;
  float* wsf = (float*)(lds + LDS_WS) + wid * 64; float* li_l = wsf; float* al_l = wsf + 32; float* btab = (float*)(lds + LDS_TAB);
  const float tabraw = tab_l[h * 257 + (tid < 257 ? tid : 256)];
  const int row0 = samp ? MP + b * DSEQ : b * SEQ + c0 * 64;
  const bool active = samp ? (wid == 0) : true;
  const int myc = c0 + (wid >> 1);
  const int tq0 = samp ? WCACHE : c0 * 64 + wid * 32;
  att::bf16x8 qr[8];
  { const unsigned short* Qw = Z + (size_t)(row0 + (samp ? 0 : wid * 32) + r32) * ZP + ZQ + h * HDIM + hi * 8;
#pragma unroll
    for (int d0 = 0; d0 < 8; ++d0) qr[d0] = ld8_bf(Qw + d0 * 16); }
  const int t_lo = samp ? 5 * half : (c0 >= 8 ? c0 - 8 : 0), nt = samp ? 5 - half : c0 + 4 - t_lo;
  const int sr = tid >> 4, sc = (tid & 15) * 8, vst0 = v_st(sr, sc), vst1 = v_st(32 + sr, sc);
  const int vb0 = (int)(uintptr_t)V_lds + v_rd_base(lane);
  f32x4 ra[8];
#define TLOAD(R, t) do { const int t_ = (t); \
    if (!samp) { const unsigned short* kr = Z + (size_t)(b * SEQ + t_ * 64 + sr) * ZP + h * HDIM + sc; \
        R[0] = *(const f32x4*)(kr + ZK); R[1] = *(const f32x4*)(kr + (size_t)32 * ZP + ZK); R[2] = *(const f32x4*)(kr + ZV); R[3] = *(const f32x4*)(kr + (size_t)32 * ZP + ZV); } \
    else if (t_ < 8) { const size_t off = ((((size_t)l * DBATCH + b) * WCACHE + t_ * 64 + sr) * NHEAD + h) * HDIM + sc; const float* kp = ck + off; const float* vp = cv + off; \
        R[0] = *(const f32x4*)kp; R[1] = *(const f32x4*)(kp + 4); R[2] = *(const f32x4*)(kp + (size_t)32 * NHEAD * HDIM); R[3] = *(const f32x4*)(kp + (size_t)32 * NHEAD * HDIM + 4); \
        R[4] = *(const f32x4*)vp; R[5] = *(const f32x4*)(vp + 4); R[6] = *(const f32x4*)(vp + (size_t)32 * NHEAD * HDIM); R[7] = *(const f32x4*)(vp + (size_t)32 * NHEAD * HDIM + 4); } \
    else { const unsigned short* kr = Z + (size_t)(MP + b * DSEQ + sr) * ZP + h * HDIM + sc; \
        R[0] = *(const f32x4*)(kr + ZK); R[2] = *(const f32x4*)(kr + ZV); R[1] = (f32x4){0.f, 0.f, 0.f, 0.f}; R[3] = R[1]; } } while (0)
#define CVT8(A, B) ({ u32x4 w_ = {cvtpk(A[0], A[1]), cvtpk(A[2], A[3]), cvtpk(B[0], B[1]), cvtpk(B[2], B[3])}; *reinterpret_cast<bf16x8*>(&w_); })
#define TWRITE(R, bufi, t) do { const int bo_ = (bufi) * SHM_T; bf16x8 ks0, ks1, vs0, vs1; \
    if (samp && (t) < 8) { ks0 = CVT8(R[0], R[1]); ks1 = CVT8(R[2], R[3]); vs0 = CVT8(R[4], R[5]); vs1 = CVT8(R[6], R[7]); } \
    else { ks0 = __builtin_bit_cast(bf16x8, R[0]); ks1 = __builtin_bit_cast(bf16x8, R[1]); vs0 = __builtin_bit_cast(bf16x8, R[2]); vs1 = __builtin_bit_cast(bf16x8, R[3]); } \
    *(bf16x8*)(V_lds + bo_ + vst0) = vs0; *(bf16x8*)(V_lds + bo_ + vst1) = vs1; const int kc_ = sc * 2; \
    *(bf16x8*)(K_lds + bo_ + KSWZ(sr, kc_)) = ks0; *(bf16x8*)(K_lds + bo_ + KSWZ(32 + sr, kc_)) = ks1; } while (0)
#define RESC(a) do { if (__any((a) < 1.f)) { if (hi == 0) al_l[r32] = (a); asm volatile("s_waitcnt lgkmcnt(0)" ::: "memory"); \
    _Pragma("unroll") for (int d = 0; d < 4; ++d) _Pragma("unroll") for (int r = 0; r < 16; ++r) o[d][r] *= al_l[crow(r, hi)]; } } while (0)
  float m_reg = -1e30f, l_reg = 0.f; f32x16 o[4] = {};
  TLOAD(ra, t_lo);
  __syncthreads();
  if (tid < 257) btab[tid] = tabraw * INV_SCALE;
  for (int i = 0; i < nt; ++i) {
    const int t = t_lo + i, buf = i & 1;
    TWRITE(ra, buf, t);
    __syncthreads();
    if (i + 1 < nt) TLOAD(ra, t + 1);
    const bool mine = active && (samp || (t >= myc - 8 && t <= myc));
    if (mine) {
      f32x16 p0, p1; float mn, alpha; bf16x8 pa0, pa1, pa2, pa3;
      qkt(p0, p1, K_lds + buf * SHM_T, qr, r32, hi);
      const int rel0 = tq0 - t * 64;
      if (rel0 - 63 >= 128) { const float bc = btab[256];
#pragma unroll
        for (int r = 0; r < 16; ++r) { p0[r] += bc; p1[r] += bc; } }
      else { const int relq = rel0 + r32;
#pragma unroll
        for (int r = 0; r < 16; ++r) { int e0 = relq - crow(r, hi), e1 = e0 - 32;
          e0 = e0 < -128 ? -128 : (e0 > 128 ? 128 : e0); e1 = e1 < -128 ? -128 : (e1 > 128 ? 128 : e1);
          p0[r] += btab[e0 + 128]; p1[r] += btab[e1 + 128]; } }
      if (samp && t == 8) {
#pragma unroll
        for (int r = 0; r < 16; ++r) p1[r] = -1e30f; }
      partialSM(p0, p1, m_reg, mn, alpha);
      RESC(alpha);
      finishSM(p0, p1, alpha, l_reg, pa0, pa1, pa2, pa3); SBAR();
      pv_d0(o, vb0 + buf * SHM_T, pa0, pa1, pa2, pa3);
    }
  }
  if (active && samp) {
    float* P = PART + (size_t)((b * NHEAD + h) * 2 + half) * PART_STRIDE;
#pragma unroll
    for (int r = 0; r < 16; ++r) { const int orow = crow(r, hi);
#pragma unroll
      for (int d0 = 0; d0 < 4; ++d0) P[orow * 128 + d0 * 32 + r32] = o[d0][r]; }
    if (hi == 0) { P[PART_O + 2 * r32] = m_reg; P[PART_O + 2 * r32 + 1] = l_reg; }
  }
  if (active && !samp) {
    if (hi == 0) li_l[r32] = l_reg;
    asm volatile("s_waitcnt lgkmcnt(0)" ::: "memory");
    float rli[16];
#pragma unroll
    for (int r = 0; r < 16; ++r) rli[r] = __builtin_amdgcn_rcpf(li_l[crow(r, hi)]);
    unsigned short* Ow = OB + (size_t)(row0 + (samp ? 0 : wid * 32)) * ATD + h * HDIM;
#pragma unroll
    for (int r = 0; r < 16; ++r) { const int orow = crow(r, hi);
#pragma unroll
      for (int d0 = 0; d0 < 4; ++d0) Ow[(size_t)orow * ATD + d0 * 32 + r32] = (unsigned short)f2bf(o[d0][r] * rli[r]); }
  }
#undef TLOAD
#undef TWRITE
#undef CVT8
#undef RESC
}
__device__ __forceinline__ void attn_sample_combine(int task, const float* PART, unsigned short* OB, int lane) {
  const int p = task >> 5, t = task & 31, b = p >> 3, h = p & 7;
  const float* P0 = PART + (size_t)(p * 2) * PART_STRIDE; const float* P1 = P0 + PART_STRIDE;
  const float m0 = P0[PART_O + 2 * t], l0 = P0[PART_O + 2 * t + 1], m1 = P1[PART_O + 2 * t], l1 = P1[PART_O + 2 * t + 1];
  constexpr float C = SCALE * 1.4426950408889634f; const float m = fmaxf(m0, m1), w0 = __builtin_amdgcn_exp2f((m0 - m) * C), w1 = __builtin_amdgcn_exp2f((m1 - m) * C);
  const float inv = __builtin_amdgcn_rcpf(l0 * w0 + l1 * w1);
  const f32x2g a = *(const f32x2g*)(P0 + t * 128 + 2 * lane), c = *(const f32x2g*)(P1 + t * 128 + 2 * lane);
  *(unsigned*)(OB + (size_t)(MP + b * DSEQ + t) * ATD + h * HDIM + 2 * lane) = pk2((a.x * w0 + c.x * w1) * inv, (a.y * w0 + c.y * w1) * inv);
}
#undef KSWZ
#undef SBAR
}
namespace att {
template <int KS> __device__ __forceinline__ void gm_step(f32x16& o0, f32x16& o1, int vb, bf16x8 pa) {
  constexpr int TB = (KS >> 2) * SHM_T, KK = KS & 3;
  const s16x4 l0 = tr_read<TB + v_rd_off(0, KK, 0)>(vb), h0 = tr_read<TB + v_rd_off(0, KK, 1)>(vb), l1 = tr_read<TB + v_rd_off(1, KK, 0)>(vb), h1 = tr_read<TB + v_rd_off(1, KK, 1)>(vb);
  asm volatile("s_waitcnt lgkmcnt(0)" ::: "memory"); __builtin_amdgcn_sched_barrier(0);
#define PK(L, H) (bf16x8){L[0], L[1], L[2], L[3], H[0], H[1], H[2], H[3]}
  o0 = __builtin_amdgcn_mfma_f32_32x32x16_bf16(pa, PK(l0, h0), o0, 0, 0, 0);
  o1 = __builtin_amdgcn_mfma_f32_32x32x16_bf16(pa, PK(l1, h1), o1, 0, 0, 0);
#undef PK
}
__device__ __forceinline__ bf16x8 ws_frag(const f32x4 a, const f32x4 b, int s0, int t) {
  float f[8] = {a[0], a[1], a[2], a[3], b[0], b[1], b[2], b[3]};
#pragma unroll
  for (int j = 0; j < 8; ++j) f[j] = (s0 + j <= t) ? f[j] : 0.f;
  u32x4 w = {cvtpk(f[0], f[1]), cvtpk(f[2], f[3]), cvtpk(f[4], f[5]), cvtpk(f[6], f[7])}; return *reinterpret_cast<bf16x8*>(&w);
}
__device__ __forceinline__ void gm_unit(int u, const unsigned short* Z, const unsigned short* VB, const float* ws_l, const float* bs_l, unsigned short* YB, char* lds) {
  int tid_ = threadIdx.x; asm volatile("" : "+v"(tid_));
  const int tid = tid_, wid = __builtin_amdgcn_readfirstlane(tid >> 6), lane = tid & 63, r32 = lane & 31, hi = lane >> 5;
  const bool samp = u >= 512;
  const int g = samp ? (u - 512) & 7 : u & 7;
  const int chunk0 = samp ? MP + ((u - 512) >> 3) * DSEQ : (u >> 8) * SEQ + ((u >> 3) & 31) * 128;
  const int nrows = samp ? DSEQ : 128;
  const int sr = tid >> 4, sc = (tid & 15) * 8;
  bf16x8 vq[4];
#pragma unroll
  for (int q = 0; q < 4; ++q) { const int rr = (q >> 1) * 64 + (q & 1) * 32 + sr;
    vq[q] = bf16x8{}; if (rr < nrows) vq[q] = ld8_bf(VB + (size_t)(chunk0 + rr) * GMD + g * 128 + sc); }
  const int tb = wid >> 1, ch = wid & 1;
  const bool act = tb * 32 < nrows;
  const int t = tb * 32 + r32, nks = 2 * (tb + 1);
  f32x4 wa[8], wb[8]; unsigned short uq[16][2]; float bq[16];
  if (act) {
    const float* wrow = ws_l + ((size_t)g * 128 + t) * 128 + 8 * hi;
#pragma unroll
    for (int ks = 0; ks < 8; ++ks) { wa[ks] = (f32x4){0.f, 0.f, 0.f, 0.f}; wb[ks] = wa[ks]; if (ks < nks) { wa[ks] = *(const f32x4*)(wrow + 16 * ks); wb[ks] = *(const f32x4*)(wrow + 16 * ks + 4); } }
#pragma unroll
    for (int r = 0; r < 16; ++r) { const size_t row = (size_t)(chunk0 + tb * 32 + crow(r, hi)); bq[r] = bs_l[g * 128 + tb * 32 + crow(r, hi)];
#pragma unroll
      for (int dd = 0; dd < 2; ++dd) uq[r][dd] = Z[row * ZP + ZB + g * 128 + (2 * ch + dd) * 32 + r32]; }
  }
  __syncthreads();
#pragma unroll
  for (int q = 0; q < 4; ++q) *(bf16x8*)(lds + (q >> 1) * SHM_T + v_st((q & 1) * 32 + sr, sc)) = vq[q];
  __syncthreads();
  if (act) {
    f32x16 o0 = {}, o1 = {};
    const int vb = (int)(uintptr_t)lds + v_rd_base(lane) + ch * 1024;
#define GM_KS(KS) if (KS < nks) gm_step<KS>(o0, o1, vb, ws_frag(wa[KS], wb[KS], 16 * KS + 8 * hi, t));
    GM_KS(0) GM_KS(1) GM_KS(2) GM_KS(3) GM_KS(4) GM_KS(5) GM_KS(6) GM_KS(7)
#undef GM_KS
#pragma unroll
    for (int r = 0; r < 16; ++r) { const int trow = tb * 32 + crow(r, hi); const float bias = bq[r]; const size_t row = (size_t)(chunk0 + trow);
#pragma unroll
      for (int dd = 0; dd < 2; ++dd) { const int c = g * 128 + (2 * ch + dd) * 32 + r32;
        const float uu = __uint_as_float((unsigned)uq[r][dd] << 16);
        const float val = gelu_tanh(uu) * ((dd ? o1[r] : o0[r]) + bias);
        YB[row * GMD + c] = (unsigned short)f2bf(val); } }
  }
}
}
struct Args { const float* in[29]; float* out; unsigned char* ws; int ph_lo, ph_hi; };
constexpr int PH_PER_LAYER = 8, CW_CNT = 8192, N_PHASES = 1 + DEPTH * PH_PER_LAYER + 1;

typedef const __attribute__((address_space(4))) Args* KArgs;
#define PHASE_ENTER() KArgs ap = (KArgs)__builtin_amdgcn_kernarg_segment_ptr(); asm volatile("" : "+s"(ap)); \
    int tid = threadIdx.x; asm volatile("" : "+v"(tid)); \
    const int lane = tid & 63, wave = __builtin_amdgcn_readfirstlane(tid >> 6); \
    const int G = gridDim.x; const int vcu = (G % 8 == 0) ? ((int)blockIdx.x % 8) * (G / 8) + (int)blockIdx.x / 8 : (int)blockIdx.x; \
    const int gw = vcu * NWAVES + wave, NGW = G * NWAVES; unsigned char* const ws = ap->ws; float* const out = ap->out; \
    (void)lane; (void)gw; (void)NGW; (void)out; (void)ws
#define WSP(T, off) ((T*)(ws + (off)))

#ifndef PROBE_MASK
#define PROBE_MASK 0
#endif
#define REP(bit) for (int rep_ = 0; rep_ < 1 + ((PROBE_MASK >> (bit)) & 1); ++rep_)
__global__ void __launch_bounds__(NWAVES * 64, 2) enc_fwd(Args args) {
    extern __shared__ __attribute__((aligned(16))) unsigned char lds[];
    LAS unsigned char* const L = (LAS unsigned char*)lds;
    { const int tid0 = threadIdx.x;
      for (int u = tid0; u < (LDS_BYTES - LDSCTL_OFF) / 4; u += NWAVES * 64) ((LAS unsigned*)(L + LDSCTL_OFF))[u] = 0u; }
    __syncthreads();
    if (!MK_PER_PHASE) { (void)xcd_barrier_post((unsigned*)((gu32*)(args.ws + WS_CTL) + CW_BAR), (volatile LAS unsigned*)(L + MISC_OFF) + 8); }
    const int lo = args.ph_lo, hi = args.ph_hi;
#if defined(TLB_TOUCH)
    if (lo == 0) { const int idx_ = ((int)blockIdx.x >> 3) * (NWAVES * 64) + (int)threadIdx.x, str_ = ((int)gridDim.x >> 3) * (NWAVES * 64); unsigned acc_ = 0u;
#define TOUCH(base, bytes) for (size_t off_ = (size_t)idx_ << 21; off_ < (size_t)(bytes); off_ += (size_t)str_ << 21) acc_ += __builtin_nontemporal_load((const unsigned*)((const char*)(base) + off_))
        TOUCH(args.in[8], (size_t)DEPTH * DM * INC * 4); TOUCH(args.in[23], (size_t)DEPTH * DM * DFF * 4); TOUCH(args.in[24], (size_t)DEPTH * DM * DFF * 4); TOUCH(args.in[21], (size_t)DEPTH * DM * DM * 4); TOUCH(args.in[26], (size_t)DEPTH * DM * DM * 4);
        TOUCH(args.in[13], (size_t)DEPTH * CONVD * DM * 4); TOUCH(args.in[18], (size_t)DEPTH * CONVD * DM * 4); TOUCH(args.in[20], (size_t)DEPTH * CONVD * DM * 4); TOUCH(args.in[0], (size_t)MP * DM * 4); TOUCH(args.in[2], (size_t)DEPTH * MP * PLED * 4);
        TOUCH(args.in[5], (size_t)DEPTH * DBATCH * WCACHE * ATD * 4); TOUCH(args.in[6], (size_t)DEPTH * DBATCH * WCACHE * ATD * 4); TOUCH(args.ws, WS_END); TOUCH(args.out, O_END * 4);
#undef TOUCH
        if (acc_ == 0x9e3779b9u && threadIdx.x == 7777) __hip_atomic_store((gu32*)args.ws + 3, acc_, RLX_AGENT); }
#endif
#define IN(k) (lo <= (k) && (k) < hi)
#define SEAM(k) do { if (IN((k) + 1)) { if (MK_PER_PHASE) { if (threadIdx.x == 0) __hip_atomic_store((gu32*)ws, 0xBADBA0u, RLX_AGENT); } \
        else { XcdBarrier bar_; bar_.bar = (unsigned*)((gu32*)(ws + WS_CTL) + CW_BAR); bar_.x = xb_xcc_id(); bar_.st = (volatile LAS unsigned*)(L + MISC_OFF) + 8; REP(7) xcd_barrier(bar_); } } } while (0)

    for (int pass_ = 0; pass_ < 1 + ((PROBE_MASK >> 12) & 1); ++pass_) {
    if (IN(0)) {
        PHASE_ENTER();
        LAS float* scr = (LAS float*)(L + RING_OFF + wave * 16384);
        REP(0) {
        constexpr int I_IN = (DM / 64) * (INC / 256), I_BR = (CONVD / 64) * (DM / 256), I_O = (DM / 64) * (DM / 256), I_F1 = (DM / 64) * (DFF / 256), I_F2 = (DFF / 64) * (DM / 256), I_PG = I_O, I_PP = (PLED / 64) * (DM / 256);
        constexpr int I_LAYER = I_IN + 3 * I_BR + I_O + I_F1 + I_F2 + I_PG + I_PP;
#define P0_DESC(d, itv) do { d.gain = nullptr; d.glu = 0; const int l_ = (itv) / I_LAYER; int r_ = (itv) % I_LAYER; unsigned char* wl_ = ws + WS_WT + (size_t)l_ * WT_LAYER; \
            if (r_ < I_IN) { d.W = ap->in[8] + (size_t)l_ * DM * INC; d.K = DM; d.N = INC; d.WT = (bf16*)(wl_ + WT_IN); d.gain = ap->in[7] + (size_t)l_ * DM; d.glu = CONVD; } else { r_ -= I_IN; \
            if (r_ < I_BR) { d.W = ap->in[13] + (size_t)l_ * CONVD * DM; d.K = CONVD; d.N = DM; d.WT = (bf16*)(wl_ + WT_A); } else { r_ -= I_BR; \
            if (r_ < I_BR) { d.W = ap->in[18] + (size_t)l_ * GMD * DM; d.K = GMD; d.N = DM; d.WT = (bf16*)(wl_ + WT_B); } else { r_ -= I_BR; \
            if (r_ < I_BR) { d.W = ap->in[20] + (size_t)l_ * ATD * DM; d.K = ATD; d.N = DM; d.WT = (bf16*)(wl_ + WT_C); } else { r_ -= I_BR; \
            if (r_ < I_O) { d.W = ap->in[21] + (size_t)l_ * DM * DM; d.K = DM; d.N = DM; d.WT = (bf16*)(wl_ + WT_O); } else { r_ -= I_O; \
            if (r_ < I_F1) { d.W = ap->in[23] + (size_t)l_ * DM * DFF; d.K = DM; d.N = DFF; d.WT = (bf16*)(wl_ + WT_F1); d.gain = ap->in[22] + (size_t)l_ * DM; } else { r_ -= I_F1; \
            if (r_ < I_F2) { d.W = ap->in[24] + (size_t)l_ * DFF * DM; d.K = DFF; d.N = DM; d.WT = (bf16*)(wl_ + WT_F2); } else { r_ -= I_F2; \
            if (r_ < I_PG) { d.W = ap->in[26] + (size_t)l_ * DM * DM; d.K = DM; d.N = DM; d.WT = (bf16*)(wl_ + WT_PG); d.gain = ap->in[25] + (size_t)l_ * DM; } else { r_ -= I_PG; \
            d.W = ap->in[27] + (size_t)l_ * PLED * DM; d.K = PLED; d.N = DM; d.WT = (bf16*)(wl_ + WT_PP); } } } } } } } } d.r = r_; d.ldw = (d.K == DFF) ? LD_T : (d.K == DM ? LD2 : d.K); } while (0)
        { f32x4 va[8], vb[8]; float ga[8], gb[8], gc[8]; P0Item dc, d0, d1; int it = vcu; LAS float* T = (LAS float*)(L + RING_OFF); constexpr int TOT_ = DEPTH * I_LAYER;
          bool h0 = it < TOT_, h1 = it + G < TOT_;
          { const int i0_ = h0 ? it : TOT_ - 1; P0_DESC(d0, i0_); p0w_load(d0, va, ga, wave, lane); }
          { const int i1_ = h1 ? it + G : TOT_ - 1; P0_DESC(d1, i1_); p0w_load(d1, vb, gb, wave, lane); }
#define P0_STEP(VA, GA, DA, HA, ITN) do { p0w_store(VA, T, wave, lane); _Pragma("unroll") for (int i = 0; i < 8; ++i) gc[i] = GA[i]; __syncthreads(); dc = DA; HA = (ITN) < TOT_; \
              { const int in_ = HA ? (ITN) : TOT_ - 1; P0_DESC(DA, in_); p0w_load(DA, VA, GA, wave, lane); } p0w_flush(dc, gc, T, wave, lane); __syncthreads(); } while (0)
          for (;;) { if (!h0) break; P0_STEP(va, ga, d0, h0, it + 2 * G); if (!h1) break; P0_STEP(vb, gb, d1, h1, it + 3 * G); it += 2 * G; }
#undef P0_STEP
        }
#undef P0_DESC
        bf16* const PLEB = WSP(bf16, WS_PLE);
        for (int row = gw; row < MTOK; row += NGW) {
            const float* src = row < MP ? ap->in[0] + (size_t)row * DM : ap->in[1] + (size_t)(row - MP) * DM;
            const f32x4* s4 = (const f32x4*)src + lane; u32x2g* b4 = (u32x2g*)(WSP(bf16, WS_H) + (size_t)row * DM) + lane; float ss = 0.f;
            f32x4 vv_[8];
#pragma unroll
            for (int j = 0; j < 8; ++j) vv_[j] = s4[64 * j];
#pragma unroll
            for (int j = 0; j < 8; ++j) { const f32x4 v = vv_[j]; u32x2g w; w.x = pk2(v[0], v[1]); w.y = pk2(v[2], v[3]); b4[64 * j] = w; ss += (v[0] * v[0] + v[1] * v[1]) + (v[2] * v[2] + v[3] * v[3]); }
            ss = wave_sum(ss, lane); if (lane == 0) pg8::ss_store(WSP(pg8::ssq_t, WS_SS) + 2 * MTOK + row, ss);
        }
        for (int r0 = gw; r0 < DEPTH * MTOK; r0 += 4 * NGW) {
            f32x4 v_[4];
#pragma unroll
            for (int k = 0; k < 4; ++k) { const int r = r0 + k * NGW; if (r < DEPTH * MTOK) { const int l = r / MTOK, row = r % MTOK;
                const float* src = row < MP ? ap->in[2] + ((size_t)l * MP + row) * PLED : ap->in[3] + ((size_t)l * MS + (row - MP)) * PLED; v_[k] = ((const f32x4*)src)[lane]; } }
#pragma unroll
            for (int k = 0; k < 4; ++k) { const int r = r0 + k * NGW; if (r < DEPTH * MTOK) { const f32x4 v = v_[k]; u32x2g w; w.x = pk2(v[0], v[1]); w.y = pk2(v[2], v[3]); ((u32x2g*)(PLEB + (size_t)r * PLED))[lane] = w; } }
        }
        }
        SEAM(0);
    }

    for (int l = 0; l < DEPTH; ++l) {
        const int pb = 1 + l * PH_PER_LAYER;
#define WL(off) ((const bf16*)(ws + WS_WT + (size_t)l * WT_LAYER + (off)))
#define GEMM_CALL(EPI, Aptr, Bptr, NN, KK, ...) GEMM_CALL_LD(EPI, Aptr, Bptr, NN, KK, 0, 0, __VA_ARGS__)
#define GEMM_CALL_LD(EPI, Aptr, Bptr, NN, KK, LDA, LDB, ...) do { pg8::Gemm g_{Aptr, Bptr, MTOK, NN, KK, 0, 0, LDA, LDB}; pg8::StaticOrder S_; S_.init(MTOK, NN, KK, (int)gridDim.x, (int)blockIdx.x); EPI E_{__VA_ARGS__}; \
        pg8::gemm_phase<EPI, pg8::StaticOrder, PG8_ALIGN, PG8_SP2>(L + RING_OFF, g_, S_, E_); } while (0)
#define GEMM_SPLIT(EPI, Aptr, Bptr, NN, KK, SS, ...) GEMM_SPLIT_LD(EPI, Aptr, Bptr, NN, KK, 0, 0, SS, __VA_ARGS__)
#define GEMM_SPLIT_LD(EPI, Aptr, Bptr, NN, KK, LDA, LDB, SS, ...) do { pg8::Gemm g_{Aptr, Bptr, MTOK, NN, KK, 0, 0, LDA, LDB}; pg8::SplitOrder S_; S_.init(MP, NN, KK, SS, (int)gridDim.x, (int)blockIdx.x); EPI E_{__VA_ARGS__}; \
        pg8::gemm_phase<EPI, pg8::SplitOrder, PG8_ALIGN, PG8_SP2>(L + RING_OFF, g_, S_, E_); } while (0)
#define SSA (WSP(pg8::ssq_t, WS_SS))
#define SSB (WSP(pg8::ssq_t, WS_SS) + MTOK)
#define SSC (WSP(pg8::ssq_t, WS_SS) + 2 * MTOK)
#define HBA (WSP(bf16, WS_XN))
#define HBB (WSP(bf16, WS_H))
#define FIXSET(F0, FN) const int fn_ = ((int)gridDim.x == 256) ? (FN) : (int)gridDim.x, fj_ = (int)blockIdx.x - (((int)gridDim.x == 256) ? (F0) : 0)
#define FIX_ROWS(e, F0, FN, S, MODE, HIN, SSI, HBO, SSO) do { FIXSET(F0, FN); if (fj_ >= 0 && fj_ < fn_) { LAS float* red_ = (LAS float*)(L + RING_OFF); int par_ = 0; \
            for (int rs = fj_; rs < MS; rs += 2 * fn_, ++par_) sample_rows_fix<S, MODE, false>(rs, fn_, rs + fn_ < MS, par_, HIN, WSP(bf16, WS_SLAB), (WSP(bf16, WS_PP4) + (size_t)(l > 0 ? l - 1 : 0) * MTOK * DM), SSI, HBO, SSO, nullptr, nullptr, red_, wave, lane); \
            PUBLISH(e); } } while (0)
#define PUBLISH(e) do { asm volatile("s_waitcnt vmcnt(0)" ::: "memory"); __syncthreads();     \
            if (threadIdx.x == 0) (void)__hip_atomic_fetch_add((gu32*)(ws + WS_CTL) + CW_CNT + 64 * (l * 8 + (e)), 1u, RLX_AGENT); } while (0)
#define WAITALL(e, F0, FN) do { const int need = ((int)gridDim.x == 256) ? (FN) : (int)gridDim.x; if (threadIdx.x < 64) { gu32* cnt_ = (gu32*)(ws + WS_CTL) + CW_CNT + 64 * (l * 8 + (e)); unsigned sp_ = 0u; \
                while ((unsigned)__builtin_amdgcn_readfirstlane(__hip_atomic_load(cnt_, RLX_AGENT)) < (unsigned)(need)) { __builtin_amdgcn_s_sleep(2); \
                    if (++sp_ > (1u << 20)) { if (threadIdx.x == 0) __hip_atomic_store((gu32*)(ws + WS_CTL) + CW_BAR + XB_TMO, 1u, RLX_AGENT); break; } } \
                __builtin_amdgcn_fence(__ATOMIC_ACQUIRE, "agent"); asm volatile("s_waitcnt vmcnt(0)" ::: "memory"); } \
            __syncthreads(); } while (0)
        if (IN(pb + 0)) { PHASE_ENTER();
            if (l > 0) FIX_ROWS(0, 232, 24, 8, 2, HBA, SSB, HBB, SSC);
            REP(4) {
            { pg8::Gemm g_{HBB, WL(WT_IN), MP, INC, DM, 0, 0, 0, LD2}; pg8::StaticOrder S_; S_.init(MP, INC, DM, (int)gridDim.x, (int)blockIdx.x, 1); pg8::EpiZ E_{WSP(bf16, WS_Z), ZP, SSC, WSP(unsigned char, WS_G8), 3 * DM, ZG / 256, 2 * CONVD / 256};
              pg8::gemm_phase<pg8::EpiZ, pg8::StaticOrder, PG8_ALIGN, PG8_SP2>(L + RING_OFF, g_, S_, E_); }
            if (l > 0) WAITALL(0, 232, 24);
            { const int G_ = (int)gridDim.x, nb_ = (MP / 256) * (INC / 256) % G_;
              const bool sub_ = nb_ > 0 && nb_ < G_;
              if (!sub_ || (int)blockIdx.x >= nb_) { pg8::Gemm g_{HBB + (size_t)MP * DM, WL(WT_IN), MS, INC, DM, 0, 0, 0, LD2}; pg8::StaticOrder S_; S_.init(MS, INC, DM, sub_ ? G_ - nb_ : G_, sub_ ? (int)blockIdx.x - nb_ : (int)blockIdx.x, 2);
                  pg8::EpiZ E_{WSP(bf16, WS_Z) + (size_t)MP * ZP, ZP, SSC + MP, WSP(unsigned char, WS_G8) + (size_t)MP * 3 * DM, 3 * DM, ZG / 256, 2 * CONVD / 256};
                  pg8::gemm_phase<pg8::EpiZ, pg8::StaticOrder, PG8_ALIGN, PG8_SP2>(L + RING_OFF, g_, S_, E_); } }
            }
            SEAM(pb + 0); }
        if (IN(pb + 1)) { PHASE_ENTER(); const bf16* const Z = WSP(bf16, WS_Z);
            for (int i = gw * 64 + lane; i < 3 * MTOK; i += NGW * 64) pg8::ss_store(WSP(pg8::ssq_t, WS_SS) + i, 0.f);
            REP(2) {
            REP(14) for (int run = vcu; run < CONV_RUNS; run += G) {
                conv_unit(l, run * 8 + wave, Z, ap->in[4], ap->in[9] + (size_t)l * CONVW * CONVD, ap->in[10] + (size_t)l * CONVD, WSP(float, WS_MG), out, lane);
                asm volatile("s_waitcnt vmcnt(0)" ::: "memory"); __syncthreads();
                { const bool samp_ = run >= PBATCH * RUNS_PB; const int t0_ = samp_ ? 0 : (run % RUNS_PB) * CONV_R, len_ = samp_ ? DSEQ : (SEQ - t0_ < CONV_R ? SEQ - t0_ : CONV_R);
                  const int row0_ = samp_ ? MP + (run - PBATCH * RUNS_PB) * DSEQ : (run / RUNS_PB) * SEQ + t0_;
                  conv_ln_rows(row0_, wave, NWAVES, len_, WSP(float, WS_MG), ap->in[11] + (size_t)l * CONVD, ap->in[12] + (size_t)l * CONVD, WSP(bf16, WS_YA), lane); }
            }
            REP(15) gmlp_v_rows(l, gw, NGW, MTOK, Z, ap->in[14] + (size_t)l * GMD, ap->in[15] + (size_t)l * GMD, WSP(bf16, WS_V), out, lane);
            REP(15) for (int row = gw; row < MTOK; row += NGW) kv_rows(l, row, Z, out, lane);
            REP(16) for (int u = vcu; u < 512; u += G) att::attn_unit(l, u, Z, ap->in[5], ap->in[6], ap->in[19] + (size_t)l * NHEAD * 257, WSP(bf16, WS_O), WSP(float, WS_MG + 34 * MiB), (char*)lds);
            }
            SEAM(pb + 1); }
        if (IN(pb + 2)) { PHASE_ENTER();
            REP(3) {
            for (int task = gw; task < DBATCH * NHEAD * DSEQ; task += NGW) att::attn_sample_combine(task, WSP(float, WS_MG + 34 * MiB), WSP(bf16, WS_O), lane);
            for (int u = vcu; u < 640; u += G) att::gm_unit(u, WSP(bf16, WS_Z), WSP(bf16, WS_V), ap->in[16] + (size_t)l * 8 * 128 * 128, ap->in[17] + (size_t)l * 8 * 128, WSP(bf16, WS_YB), (char*)lds);
            }
            SEAM(pb + 2); }
        if (IN(pb + 3)) { PHASE_ENTER(); REP(6) {
            pg8::Gemm g_{WSP(bf16, WS_YA), WL(WT_A), MTOK, DM, CONVD, (size_t)(WS_YB - WS_YA), (size_t)(WT_B - WT_A)}; pg8::BranchOrder S_; S_.init(MP, DM, CONVD, 4, (int)gridDim.x, (int)blockIdx.x);
            pg8::EpiBranchFused E_{WSP(unsigned char, WS_G8), 3 * DM, WSP(bf16, WS_MERGED), DM, WSP(bf16, WS_SLAB), MP / 256};
            pg8::gemm_phase<pg8::EpiBranchFused, pg8::BranchOrder, PG8_ALIGN, PG8_SP2>(L + RING_OFF, g_, S_, E_); }
            SEAM(pb + 3); }
        if (IN(pb + 4)) { PHASE_ENTER();
            { FIXSET(128, 128); if (fj_ >= 0 && fj_ < fn_) {
            for (int rs = fj_; rs < MS; rs += fn_) { const int q = wave * 64 + lane; const u32x2g* sl = (const u32x2g*)(WSP(bf16, WS_SLAB) + (size_t)rs * DM) + q; f32x4 t_[12]; f32x4 a = (f32x4){0.f, 0.f, 0.f, 0.f};
#pragma unroll
                for (int s = 0; s < 12; ++s) { const u32x2g w_ = sl[(size_t)s * (MS * DM / 4)]; t_[s] = (f32x4){pg8::bf_lo(w_.x), pg8::bf_hi(w_.x), pg8::bf_lo(w_.y), pg8::bf_hi(w_.y)}; }
#pragma unroll
                for (int s = 0; s < 12; ++s) a += t_[s];
                const unsigned long long w = (unsigned long long)pk2(a[0], a[1]) | ((unsigned long long)pk2(a[2], a[3]) << 32);
                __hip_atomic_store((unsigned long long*)(WSP(bf16, WS_MERGED) + (size_t)(MP + rs) * DM) + q, w, __ATOMIC_RELAXED, __HIP_MEMORY_SCOPE_AGENT); }
            PUBLISH(1); } }
            { pg8::Gemm g_{WSP(bf16, WS_MERGED), WL(WT_O), MTOK, DM, DM, 0, 0, 0, LD2}; pg8::SplitOrder S_; S_.init(MP, DM, DM, 8, (int)gridDim.x, (int)blockIdx.x, 1); pg8::EpiResBf16Split E_{HBB, HBA, DM, WSP(bf16, WS_SLAB), MP / 256, SSA};
              pg8::gemm_phase<pg8::EpiResBf16Split, pg8::SplitOrder, PG8_ALIGN, PG8_SP2>(L + RING_OFF, g_, S_, E_); }
            WAITALL(1, 128, 128);
            { pg8::Gemm g_{WSP(bf16, WS_MERGED), WL(WT_O), MTOK, DM, DM, 0, 0, 0, LD2}; pg8::SplitOrder S_; S_.init(MP, DM, DM, 8, (int)gridDim.x, (int)blockIdx.x, 2); pg8::EpiResBf16Split E_{HBB, HBA, DM, WSP(bf16, WS_SLAB), MP / 256, SSA};
              pg8::gemm_phase<pg8::EpiResBf16Split, pg8::SplitOrder, PG8_ALIGN, PG8_SP2>(L + RING_OFF, g_, S_, E_); }
            SEAM(pb + 4); }
        if (IN(pb + 5)) { PHASE_ENTER();
            FIX_ROWS(2, 64, 192, 8, 1, HBB, nullptr, HBA, SSA);
            REP(5) {
            { pg8::Gemm g_{HBA, WL(WT_F1), MP, DFF, DM, 0, 0, 0, LD2}; pg8::StaticOrder S_; S_.init(MP, DFF, DM, (int)gridDim.x, (int)blockIdx.x); pg8::EpiBf16<1> E_{WSP(bf16, WS_T), LD_T, SSA};
              pg8::gemm_phase<pg8::EpiBf16<1>, pg8::StaticOrder, PG8_ALIGN, PG8_SP2>(L + RING_OFF, g_, S_, E_); }
            WAITALL(2, 64, 192);
            { pg8::Gemm g_{HBA + (size_t)MP * DM, WL(WT_F1), MS, DFF, DM, 0, 0, 0, LD2}; pg8::StaticOrder S_; S_.init(MS, DFF, DM, (int)gridDim.x, (int)blockIdx.x); pg8::EpiBf16<1> E_{WSP(bf16, WS_T) + (size_t)MP * LD_T, LD_T, SSA + MP};
              pg8::gemm_phase<pg8::EpiBf16<1>, pg8::StaticOrder, PG8_ALIGN, PG8_SP2>(L + RING_OFF, g_, S_, E_); }
            { const int G_ = (int)gridDim.x, nb_ = (MS / 256) * (DFF / 256) % G_;
              const bool sub_ = nb_ > 0 && nb_ < G_;
              if (!sub_ || (int)blockIdx.x >= nb_) { pg8::Gemm g_{WSP(bf16, WS_PLE) + (size_t)l * MTOK * PLED, WL(WT_PP), MTOK, DM, PLED}; pg8::StaticOrder S_; S_.init(MTOK, DM, PLED, sub_ ? G_ - nb_ : G_, sub_ ? (int)blockIdx.x - nb_ : (int)blockIdx.x);
                    pg8::EpiBf16<0> E_{WSP(bf16, WS_PP4) + (size_t)l * MTOK * DM, DM, nullptr};
                    pg8::gemm_phase<pg8::EpiBf16<0>, pg8::StaticOrder, PG8_ALIGN, PG8_SP2>(L + RING_OFF, g_, S_, E_); } } }
            SEAM(pb + 5); }
        if (IN(pb + 6)) { PHASE_ENTER(); GEMM_SPLIT_LD(pg8::EpiResBf16Split, WSP(bf16, WS_T), WL(WT_F2), DM, DFF, LD_T, LD_T, 16, HBA, HBA, DM, WSP(bf16, WS_SLAB), MP / 256, SSB);     SEAM(pb + 6); }
        if (IN(pb + 7)) { PHASE_ENTER();
            FIX_ROWS(3, 128, 128, 16, 1, HBA, nullptr, HBA, SSB);
            { pg8::Gemm g_{HBA, WL(WT_PG), MTOK, DM, DM, 0, 0, 0, LD2}; pg8::SplitOrder S_; S_.init(MP, DM, DM, 8, (int)gridDim.x, (int)blockIdx.x, 1);
              pg8::EpiPleBf16Split E_{HBA, HBB, WSP(bf16, WS_PP4) + (size_t)l * MTOK * DM, DM, WSP(bf16, WS_SLAB), MP / 256, SSB, SSC};
              pg8::gemm_phase<pg8::EpiPleBf16Split, pg8::SplitOrder, PG8_ALIGN, PG8_SP2>(L + RING_OFF, g_, S_, E_); }
            WAITALL(3, 128, 128);
            { pg8::Gemm g_{HBA, WL(WT_PG), MTOK, DM, DM, 0, 0, 0, LD2}; pg8::SplitOrder S_; S_.init(MP, DM, DM, 8, (int)gridDim.x, (int)blockIdx.x, 2);
              pg8::EpiPleBf16Split E_{HBA, HBB, WSP(bf16, WS_PP4) + (size_t)l * MTOK * DM, DM, WSP(bf16, WS_SLAB), MP / 256, SSB, SSC};
              pg8::gemm_phase<pg8::EpiPleBf16Split, pg8::SplitOrder, PG8_ALIGN, PG8_SP2>(L + RING_OFF, g_, S_, E_); }
            SEAM(pb + 7); }
    }
    if (IN(N_PHASES - 1)) { PHASE_ENTER(); LAS float* red_ = (LAS float*)(L + RING_OFF); int par_ = 0;
        for (int rs = vcu; rs < MS; rs += 2 * G, ++par_) sample_rows_fix<8, 2, true>(rs, G, rs + G < MS, par_, HBA, WSP(bf16, WS_SLAB), (WSP(bf16, WS_PP4) + (size_t)(DEPTH - 1) * MTOK * DM), SSB, nullptr, nullptr, ap->in[28], out, red_, wave, lane);
        rms_rows_bf16_to_f32(HBB, ap->in[28], out, gw, NGW, MP, lane);
        if (PROBE_MASK & 4096) { XcdBarrier bar_; bar_.bar = (unsigned*)((gu32*)(ws + WS_CTL) + CW_BAR); bar_.x = xb_xcc_id(); bar_.st = (volatile LAS unsigned*)(L + MISC_OFF) + 8; xcd_barrier(bar_); } }
    }
#undef IN
#undef SEAM
}

extern "C" void kernel_launch(void* const* d_in, const int* in_sizes, int n_in, void* d_out, int out_size, void* d_ws, size_t ws_size, hipStream_t stream) {
    static int grid = 0;
    if (grid == 0) {
        if (n_in != 29 || out_size != (int)O_END || ws_size < WS_END) { fprintf(stderr, "kernel_launch: unexpected shapes: n_in %d, out %d, ws %zu; nothing launched\n", n_in, out_size, ws_size); grid = -1; return; }
        int dev = 0, cus = 0, per_cu = 0;
        if (hipGetDevice(&dev) != hipSuccess || hipDeviceGetAttribute(&cus, hipDeviceAttributeMultiprocessorCount, dev) != hipSuccess) { fprintf(stderr, "kernel_launch: device query failed\n"); grid = -1; return; }
        if (hipFuncSetAttribute((const void*)enc_fwd, hipFuncAttributeMaxDynamicSharedMemorySize, LDS_BYTES) != hipSuccess) { fprintf(stderr, "kernel_launch: hipFuncSetAttribute failed\n"); grid = -1; return; }
        if (hipOccupancyMaxActiveBlocksPerMultiprocessor(&per_cu, (const void*)enc_fwd, NWAVES * 64, LDS_BYTES) != hipSuccess || per_cu < 1) { fprintf(stderr, "kernel_launch: occupancy query reports %d workgroups per CU\n", per_cu); }
        (void)hipGetLastError();
        grid = cus;
    }
    if (grid < 0) return;
    if (hipMemsetAsync((char*)d_ws + WS_CTL, 0, CTL_ZERO_BYTES, stream) != hipSuccess) { fprintf(stderr, "kernel_launch: memset failed\n"); return; }
    Args a{};
    for (int i = 0; i < 29; ++i) a.in[i] = (const float*)d_in[i];
    a.out = (float*)d_out; a.ws = (unsigned char*)d_ws;
#if MK_PER_PHASE
    for (int p = 0; p < N_PHASES; ++p) { a.ph_lo = p; a.ph_hi = p + 1; hipLaunchKernelGGL(enc_fwd, dim3(grid), dim3(NWAVES * 64), LDS_BYTES, stream, a); }
#else
    a.ph_lo = 0; a.ph_hi = N_PHASES;
    hipLaunchKernelGGL(enc_fwd, dim3(grid), dim3(NWAVES * 64), LDS_BYTES, stream, a);
#endif
    const hipError_t le = hipPeekAtLastError();
    if (le != hipSuccess) fprintf(stderr, "kernel_launch: launch failed: %s\n", hipGetErrorName(le));
}
```
